# Optimizing an MI355X kernel written in HIP

```python
import math
import jax, jax.numpy as jnp
from jax import lax
import numpy as np

D_MODEL = 1024
BATCH = 4
SEQ = 4096
DEPTH = 2

GRID_W = 64
CTX_LEN = 256
N_MIXERS = 2
N_ATTN_LAYERS = (DEPTH + 1) // 2
N_SSM_LAYERS = DEPTH // 2
EPS = 1e-6

HEAD_DIM = 64
N_HEADS = D_MODEL // HEAD_DIM
N_KV_HEADS = N_HEADS // 4
Q_PER_KV = N_HEADS // N_KV_HEADS
Q_DIM = N_HEADS * HEAD_DIM
QKV_DIM = (N_HEADS + 2 * N_KV_HEADS) * HEAD_DIM
WINDOW = 128
BLOCK = 128
ROPE_FREQS = HEAD_DIM // 4
ROPE_BASE = 10000.0

D_INNER = 2 * D_MODEL
SSM_HEAD_DIM = 64
SSM_HEADS = D_INNER // SSM_HEAD_DIM
SSM_GROUPS = 8
HEADS_PER_GROUP = SSM_HEADS // SSM_GROUPS
D_STATE = 128
D_CONV = 3
CHUNK = 128
CONV_DIM = D_INNER + 2 * SSM_GROUPS * D_STATE
IN_PROJ_DIM = D_INNER + CONV_DIM + 2 * SSM_HEADS

D_FF = ((8 * D_MODEL // 3 + 255) // 256) * 256

kernel_name = "hybrid_swa_ssd_diffusion_trunk"

F32 = jnp.float32


def rmsnorm(x, g):
    x32 = x.astype(F32)
    y = x32 * lax.rsqrt(jnp.mean(x32 * x32, axis=-1, keepdims=True) + EPS)
    return (y * g.astype(F32)).astype(x.dtype)


def modulate(x, g, shift, scale):
    return rmsnorm(x, g) * (1 + scale) + shift


def swiglu(h, w_gate, w_up, w_down):
    return (jax.nn.silu(h @ w_gate) * (h @ w_up)) @ w_down


def axial_rope_tables(L):
    rows = L // GRID_W
    row = jnp.repeat(jnp.arange(rows, dtype=F32), GRID_W)
    col = jnp.tile(jnp.arange(GRID_W, dtype=F32), rows)
    inv = ROPE_BASE ** (-jnp.arange(ROPE_FREQS, dtype=F32) / ROPE_FREQS)
    ang = jnp.stack([row, col], axis=-1)[:, :, None] * inv
    return jnp.cos(ang), jnp.sin(ang)


def axial_rope(x, cos, sin):
    xs = x.reshape(x.shape[:-1] + (2, 2, ROPE_FREQS))
    x1, x2 = xs[..., 0, :], xs[..., 1, :]
    c, s = cos[None, :, None], sin[None, :, None]
    out = jnp.stack([x1 * c - x2 * s, x2 * c + x1 * s], axis=-2)
    return out.reshape(x.shape).astype(x.dtype)


def softmax_with_sink(logits, sink):
    full = jnp.concatenate([logits, jnp.broadcast_to(sink, logits.shape[:-1] + (1,))], axis=-1)
    return jax.nn.softmax(full, axis=-1)[..., :-1]


def attention_mixer(h, hc, w_qkv, w_o, sinks, cos, sin, with_ctx_out):
    b, L, _ = h.shape
    C = hc.shape[1]
    q, k, v = jnp.split(h @ w_qkv, [Q_DIM, Q_DIM + N_KV_HEADS * HEAD_DIM], axis=-1)
    q = axial_rope(q.reshape(b, L, N_HEADS, HEAD_DIM), cos, sin)
    k = axial_rope(k.reshape(b, L, N_KV_HEADS, HEAD_DIM), cos, sin)
    v = v.reshape(b, L, N_KV_HEADS, HEAD_DIM)
    q = q.reshape(b, L, N_KV_HEADS, Q_PER_KV, HEAD_DIM)
    kc, vc = jnp.split(hc @ w_qkv[:, Q_DIM:], 2, axis=-1)
    kc = kc.reshape(b, C, N_KV_HEADS, HEAD_DIM)
    vc = vc.reshape(b, C, N_KV_HEADS, HEAD_DIM)
    sink = sinks.astype(F32).reshape(1, N_KV_HEADS, Q_PER_KV, 1, 1)
    scale = HEAD_DIM ** -0.5
    pad = ((0, 0), (BLOCK, BLOCK), (0, 0), (0, 0))
    kp, vp = jnp.pad(k, pad), jnp.pad(v, pad)
    offs_q = jnp.arange(BLOCK)
    offs_k = jnp.arange(3 * BLOCK) - BLOCK

    def block(n):
        start = n * BLOCK
        qb = lax.dynamic_slice_in_dim(q, start, BLOCK, axis=1)
        kb = lax.dynamic_slice_in_dim(kp, start, 3 * BLOCK, axis=1)
        vb = lax.dynamic_slice_in_dim(vp, start, 3 * BLOCK, axis=1)
        q_pos = start + offs_q
        k_pos = start + offs_k
        valid = ((jnp.abs(k_pos[None, :] - q_pos[:, None]) <= WINDOW)
                 & (k_pos >= 0)[None, :] & (k_pos < L)[None, :])
        s_ctx = jnp.einsum('bqgrd,bkgd->bgrqk', qb, kc).astype(F32) * scale
        s_win = jnp.einsum('bqgrd,bkgd->bgrqk', qb, kb).astype(F32) * scale
        s_win = jnp.where(valid, s_win, -jnp.inf)
        p = softmax_with_sink(jnp.concatenate([s_ctx, s_win], axis=-1), sink).astype(v.dtype)
        return (jnp.einsum('bgrqk,bkgd->bqgrd', p[..., :C], vc)
                + jnp.einsum('bgrqk,bkgd->bqgrd', p[..., C:], vb))

    o = lax.map(block, jnp.arange(L // BLOCK))
    o = jnp.moveaxis(o, 0, 1).reshape(b, L, Q_DIM)
    y = o @ w_o
    if not with_ctx_out:
        return y, None
    qc = (hc @ w_qkv[:, :Q_DIM]).reshape(b, C, N_KV_HEADS, Q_PER_KV, HEAD_DIM)
    sc = jnp.einsum('bqgrd,bkgd->bgrqk', qc, kc).astype(F32) * scale
    pc = softmax_with_sink(sc, sink).astype(vc.dtype)
    oc = jnp.einsum('bgrqk,bkgd->bqgrd', pc, vc).reshape(b, C, Q_DIM)
    return y, oc @ w_o


def centred_depthwise_conv(u, w, bias):
    K = w.shape[0]
    out = lax.conv_general_dilated(u, w[:, None, :], window_strides=(1,),
                                   padding=[(K // 2, K // 2)],
                                   dimension_numbers=('NWC', 'WIO', 'NWC'),
                                   feature_group_count=u.shape[-1])
    return out + bias


def ssm_project(u, w_in, conv_w, conv_b, dt_bias):
    b, L, _ = u.shape
    z, xbc, dt = jnp.split(u @ w_in, [D_INNER, D_INNER + CONV_DIM], axis=-1)
    xbc = jax.nn.silu(centred_depthwise_conv(xbc, conv_w, conv_b))
    xs, Bm, Cm = jnp.split(xbc, [D_INNER, D_INNER + SSM_GROUPS * D_STATE], axis=-1)
    dt = jax.nn.softplus(dt.reshape(b, L, 2, SSM_HEADS).astype(F32) + dt_bias.astype(F32))
    return (z,
            xs.reshape(b, L, SSM_GROUPS, HEADS_PER_GROUP, SSM_HEAD_DIM),
            Bm.reshape(b, L, SSM_GROUPS, D_STATE),
            Cm.reshape(b, L, SSM_GROUPS, D_STATE),
            dt.reshape(b, L, 2, SSM_GROUPS, HEADS_PER_GROUP))


def ssd_chunked(xs, dt, A, Bm, Cm, h0):
    b, L, G, HG, P = xs.shape
    nc = L // CHUNK
    x = xs.astype(F32).reshape(b, nc, CHUNK, G, HG, P)
    dt = dt.reshape(b, nc, CHUNK, G, HG)
    Bc = Bm.astype(F32).reshape(b, nc, CHUNK, G, D_STATE)
    Cc = Cm.astype(F32).reshape(b, nc, CHUNK, G, D_STATE)
    cum = jnp.cumsum(jnp.moveaxis(dt * A, 2, -1), axis=-1)
    xdt = x * dt[..., None]
    tri = jnp.tril(jnp.ones((CHUNK, CHUNK), dtype=bool))
    decay = jnp.exp(jnp.where(tri, cum[..., :, None] - cum[..., None, :], -jnp.inf))
    cb = jnp.einsum('bcign,bcjgn->bcgij', Cc, Bc)
    y_diag = jnp.einsum('bcghij,bcjghp->bcighp', cb[:, :, :, None] * decay, xdt)
    to_end = jnp.exp(cum[..., -1:] - cum)
    states = jnp.einsum('bcghj,bcjgn,bcjghp->bcghpn', to_end, Bc, xdt)
    chunk_decay = jnp.exp(cum[..., -1])

    def step(hs, inp):
        s, d = inp
        return d[..., None, None] * hs + s, hs

    h_final, h_start = lax.scan(step, h0.astype(F32),
                                (jnp.moveaxis(states, 1, 0), jnp.moveaxis(chunk_decay, 1, 0)))
    h_start = jnp.moveaxis(h_start, 0, 1)
    y_off = jnp.einsum('bcign,bcghpn,bcghi->bcighp', Cc, h_start, jnp.exp(cum))
    return (y_diag + y_off).reshape(b, L, G, HG, P).astype(xs.dtype), h_final


def ssd_final_state(xs, dt, A, Bm):
    cum = jnp.cumsum(dt * A, axis=1)
    decay = jnp.exp(cum[:, -1:] - cum)
    return jnp.einsum('blgh,blgn,blghp->bghpn', decay * dt, Bm.astype(F32), xs.astype(F32))


def bidirectional_ssd(xs, dt, A, Bm, Cm, h0_fwd, h0_bwd):
    flip = lambda u: jnp.flip(u, axis=1)
    y_f, h_f = ssd_chunked(xs, dt[:, :, 0], A[0], Bm, Cm, h0_fwd)
    y_b, h_b = ssd_chunked(flip(xs), flip(dt[:, :, 1]), A[1], flip(Bm), flip(Cm), h0_bwd)
    return y_f + flip(y_b), h_f, h_b


def ssm_output(y, xs, z, D_skip, norm_g, w_out):
    b, L = y.shape[:2]
    y = y + D_skip.reshape(SSM_GROUPS, HEADS_PER_GROUP)[:, :, None] * xs
    y = y.reshape(b, L, SSM_GROUPS, D_INNER // SSM_GROUPS) * jax.nn.silu(z).reshape(b, L, SSM_GROUPS, -1)
    y = rmsnorm(y, norm_g.reshape(SSM_GROUPS, -1))
    return y.reshape(b, L, D_INNER) @ w_out


def ssm_mixer(h, hc, w_in, conv_w, conv_b, dt_bias, A_log, D_skip, norm_g, w_out, with_ctx_out):
    A = -jnp.exp(A_log.astype(F32)).reshape(2, SSM_GROUPS, HEADS_PER_GROUP)
    zc, xc, Bc, Cc, dtc = ssm_project(hc, w_in, conv_w, conv_b, dt_bias)
    if with_ctx_out:
        zeros = jnp.zeros((hc.shape[0], SSM_GROUPS, HEADS_PER_GROUP, SSM_HEAD_DIM, D_STATE), F32)
        yc, hc_f, hc_b = bidirectional_ssd(xc, dtc, A, Bc, Cc, zeros, zeros)
        out_c = ssm_output(yc, xc, zc, D_skip, norm_g, w_out)
    else:
        hc_f = ssd_final_state(xc, dtc[:, :, 0], A[0], Bc)
        hc_b = ssd_final_state(jnp.flip(xc, 1), jnp.flip(dtc[:, :, 1], 1), A[1], jnp.flip(Bc, 1))
        out_c = None
    z, xs, Bm, Cm, dt = ssm_project(h, w_in, conv_w, conv_b, dt_bias)
    y, _, _ = bidirectional_ssd(xs, dt, A, Bm, Cm, hc_f, hc_b)
    return ssm_output(y, xs, z, D_skip, norm_g, w_out), out_c


def setup_inputs(seed: int = 0) -> dict:
    key = jax.random.key(seed)
    ks = jax.random.split(key, 24)
    nrm = lambda k, shape, s: jax.random.normal(k, shape, F32) * s
    dt_init = jnp.exp(jax.random.uniform(ks[16], (N_SSM_LAYERS, 2, SSM_HEADS), F32,
                                         minval=math.log(1e-3), maxval=math.log(1e-1)))
    return {
        "x": nrm(ks[0], (BATCH, SEQ, D_MODEL), 1.0),
        "c": nrm(ks[1], (BATCH, D_MODEL), 1.0),
        "ctx": nrm(ks[2], (BATCH, CTX_LEN, D_MODEL), 1.0),
        "c_ctx": nrm(ks[3], (D_MODEL,), 1.0),
        "ada_w": nrm(ks[4], (DEPTH, D_MODEL, 6 * D_MODEL), 0.5 * D_MODEL ** -0.5),
        "ada_b": nrm(ks[5], (DEPTH, 6 * D_MODEL), 0.01),
        "norm_mix_g": 1.0 + nrm(ks[6], (DEPTH, D_MODEL), 0.05),
        "norm_ffn_g": 1.0 + nrm(ks[7], (DEPTH, D_MODEL), 0.05),
        "attn_w_qkv": nrm(ks[8], (N_ATTN_LAYERS, D_MODEL, QKV_DIM), D_MODEL ** -0.5),
        "attn_w_o": nrm(ks[9], (N_ATTN_LAYERS, Q_DIM, D_MODEL), Q_DIM ** -0.5),
        "attn_sinks": nrm(ks[10], (N_ATTN_LAYERS, N_HEADS), 1.0),
        "ssm_w_in": nrm(ks[11], (N_SSM_LAYERS, D_MODEL, IN_PROJ_DIM), D_MODEL ** -0.5),
        "ssm_conv_w": nrm(ks[12], (N_SSM_LAYERS, D_CONV, CONV_DIM), D_CONV ** -0.5),
        "ssm_conv_b": nrm(ks[13], (N_SSM_LAYERS, CONV_DIM), 0.01),
        "ssm_dt_bias": dt_init + jnp.log(-jnp.expm1(-dt_init)),
        "ssm_A_log": jnp.log(jax.random.uniform(ks[14], (N_SSM_LAYERS, 2, SSM_HEADS), F32, minval=1.0, maxval=16.0)),
        "ssm_D": 1.0 + nrm(ks[15], (N_SSM_LAYERS, SSM_HEADS), 0.1),
        "ssm_norm_g": 1.0 + nrm(ks[17], (N_SSM_LAYERS, D_INNER), 0.05),
        "ssm_w_out": nrm(ks[18], (N_SSM_LAYERS, D_INNER, D_MODEL), D_INNER ** -0.5),
        "ffn_w_gate": nrm(ks[19], (DEPTH, D_MODEL, D_FF), D_MODEL ** -0.5),
        "ffn_w_up": nrm(ks[20], (DEPTH, D_MODEL, D_FF), D_MODEL ** -0.5),
        "ffn_w_down": nrm(ks[21], (DEPTH, D_FF, D_MODEL), D_FF ** -0.5),
        "final_norm_g": 1.0 + nrm(ks[22], (D_MODEL,), 0.05),
    }


def reference(x, c, ctx, c_ctx, ada_w, ada_b, norm_mix_g, norm_ffn_g, attn_w_qkv, attn_w_o,
              attn_sinks, ssm_w_in, ssm_conv_w, ssm_conv_b, ssm_dt_bias, ssm_A_log, ssm_D,
              ssm_norm_g, ssm_w_out, ffn_w_gate, ffn_w_up, ffn_w_down, final_norm_g):
    L = x.shape[1]
    cos, sin = axial_rope_tables(L)
    for i in range(DEPTH):
        last = i == DEPTH - 1
        j = i // N_MIXERS
        mod = jax.nn.silu(c) @ ada_w[i] + ada_b[i]
        sh1, sc1, g1, sh2, sc2, g2 = jnp.split(mod[:, None, :], 6, axis=-1)
        mod_c = jax.nn.silu(c_ctx) @ ada_w[i] + ada_b[i]
        csh1, csc1, cg1, csh2, csc2, cg2 = jnp.split(mod_c, 6)
        h = modulate(x, norm_mix_g[i], sh1, sc1)
        hc = modulate(ctx, norm_mix_g[i], csh1, csc1)
        if i % N_MIXERS == 0:
            y, yc = attention_mixer(h, hc, attn_w_qkv[j], attn_w_o[j], attn_sinks[j],
                                    cos, sin, not last)
        else:
            y, yc = ssm_mixer(h, hc, ssm_w_in[j], ssm_conv_w[j], ssm_conv_b[j], ssm_dt_bias[j],
                              ssm_A_log[j], ssm_D[j], ssm_norm_g[j], ssm_w_out[j], not last)
        x = x + g1 * y
        x = x + g2 * swiglu(modulate(x, norm_ffn_g[i], sh2, sc2),
                            ffn_w_gate[i], ffn_w_up[i], ffn_w_down[i])
        if not last:
            ctx = ctx + cg1 * yc
            ctx = ctx + cg2 * swiglu(modulate(ctx, norm_ffn_g[i], csh2, csc2),
                                     ffn_w_gate[i], ffn_w_up[i], ffn_w_down[i])
    return rmsnorm(x, final_norm_g)
```

```cpp
#include <hip/hip_runtime.h>
#include <hip/hip_cooperative_groups.h>
#include <cstdio>
#include <cstdint>
namespace cg = cooperative_groups;
namespace pg8 {
#define PG8_LAS __attribute__((address_space(3)))
typedef unsigned short bf16_t;
typedef short bf16x8 __attribute__((ext_vector_type(8)));
typedef float f32x4 __attribute__((ext_vector_type(4)));
typedef unsigned u32x4 __attribute__((ext_vector_type(4)));
constexpr int BM = 256, BK = 64, HALF = 128, HTB = HALF * BK * 2  , STAGE_BYTES = 8 * HTB, NXCD = 8, WGM = 8;

__host__ __device__ __forceinline__ int lds_byte(int r, int c) { const int st = (r >> 4) * 2 + (c >> 5), rr = r & 15, cc = c & 31, ob = rr * 64 + cc * 2; return st * 1024 + (ob ^ (((ob >> 9) & 1) << 5)); }
__host__ __device__ __forceinline__ void stage_rc(int b, int& R, int& C) { const int st = b / 1024, sb = b % 1024, swz = sb ^ (((sb >> 9) & 1) << 5); R = (st >> 1) * 16 + swz / 64; C = (st & 1) * 32 + (swz % 64) / 2; }
__host__ __device__ __forceinline__ int perm32(int rho) { const int n = rho >> 4, i = rho & 15; return 8 * (i >> 2) + 4 * n + (i & 3); }

struct Unit { int pm, pn, pk; };
struct Gemm { const bf16_t* A; const bf16_t* Bt; int M, N, K, ld; };

struct StaticOrder {
    int nM, nN, nwg, G, c;
    __host__ __device__ void init(int M, int N, int G_, int c_) { nM = M / BM; nN = N / BM; nwg = nM * nN; G = G_; c = c_; }
    __host__ __device__ bool next(int i, Unit& u) const {
        const long L = (long)i * G + c; if (L >= nwg) return false;
        int wgid = (int)L; { const int q = nwg / NXCD, r = nwg % NXCD, xcd = wgid % NXCD, off = wgid / NXCD; wgid = (xcd < r ? xcd * (q + 1) : r * (q + 1) + (xcd - r) * q) + off; }
        const int nig = WGM * nN, gid = wgid / nig, fm = gid * WGM, gsz = (nM - fm) < WGM ? (nM - fm) : WGM;
        u.pm = fm + ((wgid % nig) % gsz); u.pn = (wgid % nig) / gsz; u.pk = 0; return true;
    }
    __device__ __forceinline__ void a_ready(const Unit&) const {}
    __device__ __forceinline__ void done(const Unit&) const {}
};
struct SplitOrder {
    int pm0, npm, nN, ns, G, c;
    __host__ __device__ bool next(int i, Unit& u) const { const int L = i * G + c; if (L >= npm * nN * ns) return false; u.pk = L % ns; const int r = L / ns; u.pn = r % nN; u.pm = pm0 + r / nN; return true; }
    __device__ __forceinline__ void a_ready(const Unit&) const {}
    __device__ __forceinline__ void done(const Unit&) const {}
};
__device__ __forceinline__ unsigned cvt_pk_bf16(float lo, float hi) { unsigned r; asm volatile("v_cvt_pk_bf16_f32 %0, %1, %2" : "=v"(r) : "v"(lo), "v"(hi)); return r; }
template <class Epi, class Sched, bool ALIGN_EPI = false, bool SP2 = false>
__device__ __forceinline__ void gemm_phase(PG8_LAS unsigned char* lds, const Gemm g, const Sched& S, const Epi& E) {
    const int tid = threadIdx.x, wid = __builtin_amdgcn_readfirstlane(tid >> 6), lane = tid & 63, wr = wid >> 2, wc = wid & 3, fr = lane & 15, fq = lane >> 4;
    const int K = g.K, nt = K / BK, LD = g.ld;
    unsigned voffA[2], voffB[2];
#pragma unroll
    for (int i = 0; i < 2; ++i) { int R, C; stage_rc(tid * 16 + i * 8192, R, C); const int Rb = Epi::PERM ? ((R & ~31) + perm32(R & 31)) : R;
        voffA[i] = (unsigned)(R * LD + C) * 2u; voffB[i] = (unsigned)(Rb * LD + C) * 2u; }
    const size_t kstep = (size_t)(BK * 2);
    const size_t hstep = (size_t)HALF * LD * 2;
    const size_t tstep = 2 * hstep;
    const unsigned ldsw = (unsigned)wid * 1024u;
    const int aoff = lds_byte(wr * 64 + fr, fq * 8), boff = lds_byte(wc * 32 + fr, fq * 8);
#define PG8_SA(b, h) (((b) * 2 + (h)) * HTB)
#define PG8_SB(b, h) ((4 + (b) * 2 + (h)) * HTB)
#define PG8_STAGE(bufoff, gbase, voff) do { _Pragma("unroll") for (int _i = 0; _i < 2; ++_i) \
        __builtin_amdgcn_global_load_lds((const unsigned*)((const char*)(gbase) + (voff)[_i]), (PG8_LAS unsigned*)(lds + (bufoff) + ldsw + _i * 8192), 16, 0, 0); } while (0)
#define PG8_LDA(dst, b, h) do { _Pragma("unroll") for (int m = 0; m < 4; ++m) _Pragma("unroll") for (int k = 0; k < 2; ++k) dst[m][k] = *(const PG8_LAS bf16x8*)(lds + PG8_SA(b, h) + aoff + m * 2048 + k * 1024); } while (0)
#define PG8_LDB(dst, b, h) do { _Pragma("unroll") for (int n = 0; n < 2; ++n) _Pragma("unroll") for (int k = 0; k < 2; ++k) dst[n][k] = *(const PG8_LAS bf16x8*)(lds + PG8_SB(b, h) + boff + n * 2048 + k * 1024); } while (0)
#define PG8_MMA(ai, bj, At, Bt) do { __builtin_amdgcn_s_setprio(1); _Pragma("unroll") for (int m = 0; m < 4; ++m) _Pragma("unroll") for (int n = 0; n < 2; ++n) _Pragma("unroll") for (int k = 0; k < 2; ++k) \
        acc[ai][bj][m][n] = __builtin_amdgcn_mfma_f32_16x16x32_bf16(Bt[n][k], At[m][k], acc[ai][bj][m][n], 0, 0, 0); __builtin_amdgcn_s_setprio(0); } while (0)
#define PG8_WAIT_V(n) asm volatile("s_waitcnt vmcnt(" #n ")" ::: "memory")
#define PG8_WAIT_L(n) asm volatile("s_waitcnt lgkmcnt(" #n ")" ::: "memory")
#define PG8_BAR __builtin_amdgcn_s_barrier()
#define PG8_SCHED __builtin_amdgcn_sched_barrier(0)
    Unit cur, nxt; int ui = 0;
    if (!S.next(0, cur)) return;
    f32x4 acc[2][2][4][2];
#pragma unroll
    for (int a = 0; a < 2; ++a)
#pragma unroll
        for (int b = 0; b < 2; ++b)
#pragma unroll
            for (int m = 0; m < 4; ++m)
#pragma unroll
                for (int n = 0; n < 2; ++n) acc[a][b][m][n] = (f32x4){0.f, 0.f, 0.f, 0.f};
    bf16x8 At[4][2], B0[2][2], B1[2][2];
    const char* cA = (const char*)g.A + (size_t)cur.pm * tstep + (size_t)cur.pk * K * 2; const char* cB = (const char*)g.Bt + (size_t)cur.pn * tstep + (size_t)cur.pk * K * 2;
    S.a_ready(cur);
    if constexpr (SP2) {
        PG8_STAGE(PG8_SB(0, 0), cB, voffB); PG8_STAGE(PG8_SB(0, 1), cB + hstep, voffB); PG8_STAGE(PG8_SA(0, 0), cA, voffA); PG8_STAGE(PG8_SA(0, 1), cA + hstep, voffA);
        if (wr == 1) PG8_BAR;
        PG8_WAIT_V(2); PG8_BAR;
        PG8_STAGE(PG8_SB(1, 0), cB + kstep, voffB); PG8_STAGE(PG8_SA(1, 0), cA + kstep, voffA); PG8_STAGE(PG8_SB(1, 1), cB + hstep + kstep, voffB);
        PG8_WAIT_V(6); PG8_BAR;
    } else {
        PG8_STAGE(PG8_SB(0, 0), cB, voffB); PG8_STAGE(PG8_SA(0, 0), cA, voffA); PG8_STAGE(PG8_SB(0, 1), cB + hstep, voffB); PG8_STAGE(PG8_SA(0, 1), cA + hstep, voffA);
        if (wr == 1) PG8_BAR;
        PG8_WAIT_V(4); PG8_BAR;
        PG8_STAGE(PG8_SB(1, 0), cB + kstep, voffB); PG8_STAGE(PG8_SA(1, 0), cA + kstep, voffA); PG8_STAGE(PG8_SB(1, 1), cB + hstep + kstep, voffB);
        PG8_WAIT_V(6); PG8_BAR;
    }
    for (;;) {
        const bool has_next = S.next(ui + 1, nxt);
        const char* nA = has_next ? (const char*)g.A + (size_t)nxt.pm * tstep + (size_t)nxt.pk * K * 2 : cA; const char* nB = has_next ? (const char*)g.Bt + (size_t)nxt.pn * tstep + (size_t)nxt.pk * K * 2 : cB;
        for (int t = 0; t < nt; t += 2) {
            const bool last = (t == nt - 2);
            const char* a1 = cA + (size_t)(t + 1) * kstep;
            const char* a2 = last ? nA : cA + (size_t)(t + 2) * kstep; const char* b2 = last ? nB : cB + (size_t)(t + 2) * kstep;
            const char* a3 = a2 + kstep; const char* b3 = b2 + kstep;
            if (last && has_next) S.a_ready(nxt);
            if constexpr (SP2) {
            PG8_LDB(B0, 0, 0); PG8_LDB(B1, 0, 1); PG8_SCHED; PG8_LDA(At, 0, 0); PG8_STAGE(PG8_SA(1, 1), a1 + hstep, voffA);
            PG8_WAIT_V(8); PG8_WAIT_L(0); PG8_BAR; PG8_MMA(0, 0, At, B0); PG8_MMA(0, 1, At, B1); PG8_BAR; PG8_SCHED;
            PG8_LDA(At, 0, 1); PG8_STAGE(PG8_SB(0, 0), b2, voffB); PG8_STAGE(PG8_SB(0, 1), b2 + hstep, voffB); PG8_STAGE(PG8_SA(0, 0), a2, voffA);
            PG8_WAIT_V(8); PG8_WAIT_L(0); PG8_BAR; PG8_MMA(1, 0, At, B0); PG8_MMA(1, 1, At, B1); PG8_BAR; PG8_SCHED;
            PG8_LDB(B0, 1, 0); PG8_LDB(B1, 1, 1); PG8_SCHED; PG8_LDA(At, 1, 0); PG8_STAGE(PG8_SA(0, 1), a2 + hstep, voffA);
            PG8_WAIT_V(8); PG8_WAIT_L(0); PG8_BAR; PG8_MMA(0, 0, At, B0); PG8_MMA(0, 1, At, B1); PG8_BAR; PG8_SCHED;
            PG8_LDA(At, 1, 1); PG8_STAGE(PG8_SB(1, 0), b3, voffB); PG8_STAGE(PG8_SB(1, 1), b3 + hstep, voffB); PG8_STAGE(PG8_SA(1, 0), a3, voffA);
            PG8_WAIT_V(8); PG8_WAIT_L(0); PG8_BAR; PG8_MMA(1, 0, At, B0); PG8_MMA(1, 1, At, B1); PG8_BAR; PG8_SCHED;
            } else {
            PG8_LDB(B0, 0, 0); PG8_SCHED; PG8_LDA(At, 0, 0); PG8_STAGE(PG8_SA(1, 1), a1 + hstep, voffA);
            PG8_WAIT_L(8); PG8_BAR; PG8_WAIT_L(0); PG8_MMA(0, 0, At, B0); PG8_BAR; PG8_SCHED;
            PG8_LDB(B1, 0, 1); PG8_STAGE(PG8_SB(0, 0), b2, voffB);
            PG8_BAR; PG8_WAIT_L(0); PG8_MMA(0, 1, At, B1); PG8_BAR;
            PG8_LDA(At, 0, 1); PG8_STAGE(PG8_SA(0, 0), a2, voffA);
            PG8_BAR; PG8_WAIT_L(0); PG8_MMA(1, 0, At, B0); PG8_BAR; PG8_SCHED;
            PG8_STAGE(PG8_SB(0, 1), b2 + hstep, voffB);
            PG8_WAIT_V(6); PG8_BAR; PG8_MMA(1, 1, At, B1); PG8_BAR;
            PG8_LDB(B0, 1, 0); PG8_SCHED; PG8_LDA(At, 1, 0); PG8_STAGE(PG8_SA(0, 1), a2 + hstep, voffA);
            PG8_WAIT_L(8); PG8_BAR; PG8_WAIT_L(0); PG8_MMA(0, 0, At, B0); PG8_BAR; PG8_SCHED;
            PG8_LDB(B1, 1, 1); PG8_STAGE(PG8_SB(1, 0), b3, voffB);
            PG8_BAR; PG8_WAIT_L(0); PG8_MMA(0, 1, At, B1); PG8_BAR;
            PG8_LDA(At, 1, 1); PG8_STAGE(PG8_SA(1, 0), a3, voffA);
            PG8_BAR; PG8_WAIT_L(0); PG8_MMA(1, 0, At, B0); PG8_BAR; PG8_SCHED;
            PG8_STAGE(PG8_SB(1, 1), b3 + hstep, voffB);
            PG8_WAIT_V(6); PG8_BAR; PG8_MMA(1, 1, At, B1); PG8_BAR;
            }
        }
        if constexpr (ALIGN_EPI) { if (wr == 0) PG8_BAR; }
        if constexpr (!Epi::AFTER_DRAIN) { E(acc, cur, wr, wc, fr, fq); S.done(cur); }
        if (!has_next) break;
#pragma unroll
        for (int a = 0; a < 2; ++a)
#pragma unroll
            for (int b = 0; b < 2; ++b)
#pragma unroll
                for (int m = 0; m < 4; ++m)
#pragma unroll
                    for (int n = 0; n < 2; ++n) acc[a][b][m][n] = (f32x4){0.f, 0.f, 0.f, 0.f};
        cur = nxt; cA = nA; cB = nB; ++ui;
        if constexpr (ALIGN_EPI) { if (wr == 1) PG8_BAR; }
    }
    PG8_WAIT_V(0);
    if constexpr (!ALIGN_EPI) { if (wr == 0) PG8_BAR; }
    PG8_BAR;
    if constexpr (Epi::AFTER_DRAIN) { E.fused(acc, cur, wr, wc, fr, fq, lds, wid, lane); S.done(cur); }
#undef PG8_SA
#undef PG8_SB
#undef PG8_STAGE
#undef PG8_LDA
#undef PG8_LDB
#undef PG8_MMA
#undef PG8_WAIT_V
#undef PG8_WAIT_L
#undef PG8_BAR
#undef PG8_SCHED
}
}

#define DI __device__ __forceinline__
#define LAS __attribute__((address_space(3)))
typedef unsigned short bf16_t;
typedef short bf16x8 __attribute__((ext_vector_type(8)));
typedef short s16x4 __attribute__((ext_vector_type(4)));
typedef float f32x4 __attribute__((ext_vector_type(4)));
typedef float f32x2 __attribute__((ext_vector_type(2)));
typedef float f32x16 __attribute__((ext_vector_type(16)));
typedef unsigned u32x4 __attribute__((ext_vector_type(4)));
typedef unsigned u32x2 __attribute__((ext_vector_type(2)));
using pg8::cvt_pk_bf16;

constexpr int DM = 1024, NB = 4, SEQ = 4096, CTXL = 256;
constexpr int ML = NB * SEQ;
constexpr int MC = NB * CTXL;
constexpr int MT = ML + MC;
constexpr int DFF = 2816, DIN = 2048, NXBC = 4096, NXBCP = 4352, VTP = 4352;
constexpr float EPS = 1e-6f;
constexpr float LOG2E = 1.4426950408889634f;
constexpr float QSCALE = 0.125f * LOG2E;

constexpr size_t MiB = 1u << 20;
constexpr size_t WS_MOD = 0;
constexpr size_t WS_SSQ = 256 * 1024;
constexpr size_t WS_BAR = 800 * 1024;
constexpr size_t WS_ROPE = 900 * 1024;
constexpr size_t CTL_BYTES = 1 * MiB;
constexpr size_t WS_CTXR = 1 * MiB;
constexpr size_t WS_HN = 5 * MiB;
constexpr size_t WS_DT = 39 * MiB;
constexpr size_t WS_WZ = 44 * MiB;
constexpr size_t WS_WOUT = 48 * MiB;
constexpr size_t WS_Q = 56 * MiB;
constexpr size_t WS_K = 90 * MiB;
constexpr size_t WS_VT = 99 * MiB;
constexpr size_t WS_HB0 = 56 * MiB;
constexpr size_t WS_XBC = 56 * MiB;
constexpr size_t WS_GU1 = 56 * MiB;
constexpr size_t WS_DN1 = 67 * MiB;
constexpr size_t WS_HB1 = 73 * MiB;
constexpr size_t WS_WXBC = 192 * MiB;
constexpr size_t WS_WQKV = 201 * MiB;
constexpr size_t WS_WO = 204 * MiB;
constexpr size_t WS_GU0 = 206 * MiB;
constexpr size_t WS_DN0 = 217 * MiB;
constexpr size_t WS_Y = 192 * MiB;
constexpr size_t WS_PARTA = 150 * MiB;
constexpr size_t WS_PARTB = 223 * MiB;
constexpr size_t WS_END = 256 * MiB;

constexpr int LDS_BYTES = 160000;

DI float bflo(unsigned u) { return __uint_as_float(u << 16); }
DI float bfhi(unsigned u) { return __uint_as_float(u & 0xffff0000u); }
DI float silu_f(float x) { return x * __builtin_amdgcn_rcpf(1.0f + __expf(-x)); }
DI float wave_sum(float v) {
#pragma unroll
    for (int o = 1; o < 64; o <<= 1) v += __shfl_xor(v, o);
    return v;
}
#define LDS_WAIT() asm volatile("s_waitcnt lgkmcnt(0)" ::: "memory")

struct EpiQKV {
    static constexpr bool PERM = false, AFTER_DRAIN = false;
    bf16_t* Q; bf16_t* K; bf16_t* VT; const float* rope;
    DI void operator()(const f32x4 (&acc)[2][2][4][2], const pg8::Unit& u, int wr, int wc, int fr, int fq) const {
        const int pn = u.pn; const bool isctx = u.pm >= 64;
#pragma unroll
        for (int ai = 0; ai < 2; ++ai)
#pragma unroll
            for (int m = 0; m < 4; ++m) {
                const int row = u.pm * 256 + ai * 128 + wr * 64 + m * 16 + fr;
                int b, t; if (!isctx) { b = row >> 12; t = row & 4095; } else { const int rc = row - ML; b = rc >> 8; t = rc & 255; }
#pragma unroll
                for (int bj = 0; bj < 2; ++bj) {
                    f32x4 v0 = acc[ai][bj][m][0], v1 = acc[ai][bj][m][1];
                    const int colt = bj * 128 + wc * 32;
                    if (pn < 5 && !isctx) {
                        const int pos = (wc & 1) ? (t & 63) : (t >> 6);
                        const f32x4 c4 = *(const f32x4*)(rope + pos * 16 + 4 * fq), s4 = *(const f32x4*)(rope + 1024 + pos * 16 + 4 * fq);
                        const f32x4 r0 = v0 * c4 - v1 * s4, r1 = v1 * c4 + v0 * s4; v0 = r0; v1 = r1;
                    }
                    if (pn < 4) {
                        v0 = v0 * QSCALE; v1 = v1 * QSCALE;
                        bf16_t* p = Q + (size_t)row * 1024 + pn * 256 + colt + 4 * fq;
                        u32x2 a; a.x = cvt_pk_bf16(v0[0], v0[1]); a.y = cvt_pk_bf16(v0[2], v0[3]); *(u32x2*)p = a;
                        u32x2 c; c.x = cvt_pk_bf16(v1[0], v1[1]); c.y = cvt_pk_bf16(v1[2], v1[3]); *(u32x2*)(p + 16) = c;
                    } else if (pn == 4) {
                        bf16_t* p = K + (size_t)row * 256 + colt + 4 * fq;
                        u32x2 a; a.x = cvt_pk_bf16(v0[0], v0[1]); a.y = cvt_pk_bf16(v0[2], v0[3]); *(u32x2*)p = a;
                        u32x2 c; c.x = cvt_pk_bf16(v1[0], v1[1]); c.y = cvt_pk_bf16(v1[2], v1[3]); *(u32x2*)(p + 16) = c;
                    } else {
                        const int g = bj * 2 + (wc >> 1); const int d0 = (wc & 1) * 32 + 4 * fq; const int pos = isctx ? 4096 + t : t;
                        bf16_t* p = VT + ((size_t)((b * 4 + g) * 64 + d0)) * VTP + pos;
#pragma unroll
                        for (int e = 0; e < 4; ++e) {
                            p[(size_t)e * VTP] = (bf16_t)(cvt_pk_bf16(v0[e], 0.f) & 0xffffu);
                            p[(size_t)(16 + e) * VTP] = (bf16_t)(cvt_pk_bf16(v1[e], 0.f) & 0xffffu);
                        }
                    }
                }
            }
    }
};

struct EpiRes {
    static constexpr bool PERM = false, AFTER_DRAIN = false;
    const float* baseL; const float* baseC; float* outL; float* outC; const float* gate;
    DI void operator()(const f32x4 (&acc)[2][2][4][2], const pg8::Unit& u, int wr, int wc, int fr, int fq) const {
        const bool isctx = u.pm >= 64; const int mrow = isctx ? 4 : (u.pm >> 4);
        const float* base = isctx ? baseC - (size_t)ML * 1024 : baseL; float* out = isctx ? outC - (size_t)ML * 1024 : outL;
#pragma unroll
        for (int bj = 0; bj < 2; ++bj)
#pragma unroll
            for (int n = 0; n < 2; ++n) {
                const int col = u.pn * 256 + bj * 128 + wc * 32 + 16 * n + 4 * fq;
                const f32x4 g4 = *(const f32x4*)(gate + mrow * 6144 + col);
#pragma unroll
                for (int ai = 0; ai < 2; ++ai)
#pragma unroll
                    for (int m = 0; m < 4; ++m) {
                        const size_t off = (size_t)(u.pm * 256 + ai * 128 + wr * 64 + m * 16 + fr) * 1024 + col;
                        const f32x4 bs = *(const f32x4*)(base + off);
                        *(f32x4*)(out + off) = bs + g4 * acc[ai][bj][m][n];
                    }
            }
    }
};

struct EpiPart {
    static constexpr bool PERM = false, AFTER_DRAIN = false;
    float* pA; float* pB;
    DI void operator()(const f32x4 (&acc)[2][2][4][2], const pg8::Unit& u, int wr, int wc, int fr, int fq) const {
        float* out = (u.pk < 10 ? pA + (size_t)u.pk * MC * 1024 : pB) - (size_t)ML * 1024;
#pragma unroll
        for (int bj = 0; bj < 2; ++bj)
#pragma unroll
            for (int n = 0; n < 2; ++n) {
                const int col = u.pn * 256 + bj * 128 + wc * 32 + 16 * n + 4 * fq;
#pragma unroll
                for (int ai = 0; ai < 2; ++ai)
#pragma unroll
                    for (int m = 0; m < 4; ++m) *(f32x4*)(out + (size_t)(u.pm * 256 + ai * 128 + wr * 64 + m * 16 + fr) * 1024 + col) = acc[ai][bj][m][n];
            }
    }
};

struct EpiSwi {
    static constexpr bool PERM = true, AFTER_DRAIN = false;
    bf16_t* H;
    DI void operator()(const f32x4 (&acc)[2][2][4][2], const pg8::Unit& u, int wr, int wc, int fr, int fq) const {
        const int col = u.pn * 128 + wc * 32 + 8 * fq;
#pragma unroll
        for (int ai = 0; ai < 2; ++ai)
#pragma unroll
            for (int m = 0; m < 4; ++m) {
                const int row = u.pm * 256 + ai * 128 + wr * 64 + m * 16 + fr;
                const f32x4 g0 = acc[ai][0][m][0], g1 = acc[ai][0][m][1], u0 = acc[ai][1][m][0], u1 = acc[ai][1][m][1];
                u32x4 w;
                w.x = cvt_pk_bf16(silu_f(g0[0]) * u0[0], silu_f(g0[1]) * u0[1]); w.y = cvt_pk_bf16(silu_f(g0[2]) * u0[2], silu_f(g0[3]) * u0[3]);
                w.z = cvt_pk_bf16(silu_f(g1[0]) * u1[0], silu_f(g1[1]) * u1[1]); w.w = cvt_pk_bf16(silu_f(g1[2]) * u1[2], silu_f(g1[3]) * u1[3]);
                *(u32x4*)(H + (size_t)row * DFF + col) = w;
            }
    }
};

struct EpiXbc {
    static constexpr bool PERM = true, AFTER_DRAIN = false;
    bf16_t* X; float* DT; const float* dtb;
    DI void operator()(const f32x4 (&acc)[2][2][4][2], const pg8::Unit& u, int wr, int wc, int fr, int fq) const {
        if (u.pn < 16) {
#pragma unroll
            for (int ai = 0; ai < 2; ++ai)
#pragma unroll
                for (int m = 0; m < 4; ++m) {
                    const int row = u.pm * 256 + ai * 128 + wr * 64 + m * 16 + fr;
#pragma unroll
                    for (int bj = 0; bj < 2; ++bj) {
                        const f32x4 v0 = acc[ai][bj][m][0], v1 = acc[ai][bj][m][1];
                        u32x4 w; w.x = cvt_pk_bf16(v0[0], v0[1]); w.y = cvt_pk_bf16(v0[2], v0[3]); w.z = cvt_pk_bf16(v1[0], v1[1]); w.w = cvt_pk_bf16(v1[2], v1[3]);
                        *(u32x4*)(X + (size_t)row * NXBC + u.pn * 256 + bj * 128 + wc * 32 + 8 * fq) = w;
                    }
                }
        } else if (wc < 2) {
#pragma unroll
            for (int n = 0; n < 2; ++n) {
                const int ct = wc * 32 + 8 * fq + 4 * n;
                const f32x4 b4 = *(const f32x4*)(dtb + ct);
#pragma unroll
                for (int ai = 0; ai < 2; ++ai)
#pragma unroll
                    for (int m = 0; m < 4; ++m) {
                        const int row = u.pm * 256 + ai * 128 + wr * 64 + m * 16 + fr;
                        const f32x4 v = acc[ai][0][m][n] + b4; f32x4 o;
#pragma unroll
                        for (int e = 0; e < 4; ++e) o[e] = v[e] > 20.f ? v[e] : log1pf(__expf(v[e]));
                        *(f32x4*)(DT + (size_t)row * 64 + ct) = o;
                    }
            }
        }
    }
};

struct EpiZ {
    static constexpr bool PERM = true, AFTER_DRAIN = false;
    bf16_t* Y; const float* ng; LAS float* P4;
    DI void operator()(f32x4 (&acc)[2][2][4][2], const pg8::Unit& u, int wr, int wc, int fr, int fq) const {
#pragma unroll
        for (int ai = 0; ai < 2; ++ai)
#pragma unroll
            for (int m = 0; m < 4; ++m) {
                const int rl = ai * 128 + wr * 64 + m * 16 + fr; const int row = u.pm * 256 + rl; float ss = 0.f;
#pragma unroll
                for (int bj = 0; bj < 2; ++bj) {
                    const bf16_t* p = Y + (size_t)row * DIN + u.pn * 256 + bj * 128 + wc * 32 + 8 * fq;
                    const u32x4 yv = *(const u32x4*)p; const f32x4 z0 = acc[ai][bj][m][0], z1 = acc[ai][bj][m][1];
                    f32x4 o0, o1;
                    o0[0] = bflo(yv.x) * silu_f(z0[0]); o0[1] = bfhi(yv.x) * silu_f(z0[1]); o0[2] = bflo(yv.y) * silu_f(z0[2]); o0[3] = bfhi(yv.y) * silu_f(z0[3]);
                    o1[0] = bflo(yv.z) * silu_f(z1[0]); o1[1] = bfhi(yv.z) * silu_f(z1[1]); o1[2] = bflo(yv.w) * silu_f(z1[2]); o1[3] = bfhi(yv.w) * silu_f(z1[3]);
                    ss += (o0[0] * o0[0] + o0[1] * o0[1]) + (o0[2] * o0[2] + o0[3] * o0[3]) + (o1[0] * o1[0] + o1[1] * o1[1]) + (o1[2] * o1[2] + o1[3] * o1[3]);
                    acc[ai][bj][m][0] = o0; acc[ai][bj][m][1] = o1;
                }
                ss += __shfl_xor(ss, 16); ss += __shfl_xor(ss, 32);
                if (fq == 0) P4[rl * 4 + wc] = ss;
            }
        asm volatile("s_waitcnt lgkmcnt(0)" ::: "memory"); __builtin_amdgcn_s_barrier(); asm volatile("" ::: "memory");
        f32x4 g[2][2];
#pragma unroll
        for (int bj = 0; bj < 2; ++bj) { g[bj][0] = *(const f32x4*)(ng + u.pn * 256 + bj * 128 + wc * 32 + 8 * fq); g[bj][1] = *(const f32x4*)(ng + u.pn * 256 + bj * 128 + wc * 32 + 8 * fq + 4); }
#pragma unroll
        for (int ai = 0; ai < 2; ++ai)
#pragma unroll
            for (int m = 0; m < 4; ++m) {
                const int rl = ai * 128 + wr * 64 + m * 16 + fr; const int row = u.pm * 256 + rl;
                const f32x4 ps = *(const LAS f32x4*)(P4 + rl * 4);
                const float rstd = 1.0f / sqrtf(((ps[0] + ps[1]) + (ps[2] + ps[3])) * (1.0f / 256.0f) + EPS);
#pragma unroll
                for (int bj = 0; bj < 2; ++bj) {
                    const f32x4 o0 = acc[ai][bj][m][0] * rstd * g[bj][0], o1 = acc[ai][bj][m][1] * rstd * g[bj][1];
                    u32x4 w; w.x = cvt_pk_bf16(o0[0], o0[1]); w.y = cvt_pk_bf16(o0[2], o0[3]); w.z = cvt_pk_bf16(o1[0], o1[1]); w.w = cvt_pk_bf16(o1[2], o1[3]);
                    *(u32x4*)(Y + (size_t)row * DIN + u.pn * 256 + bj * 128 + wc * 32 + 8 * fq) = w;
                }
            }
        asm volatile("s_waitcnt lgkmcnt(0)" ::: "memory"); __builtin_amdgcn_s_barrier(); asm volatile("" ::: "memory");
    }
};

DI void transpose_item(const float* W, int N, bf16_t* WT, int K, int k0, int n0, int drow0, LAS float* scr, int lane) {
#pragma unroll
    for (int i = 0; i < 32; ++i) { const int kk = 2 * i + (lane >> 5); scr[kk * 33 + (lane & 31)] = W[(size_t)(k0 + kk) * N + n0 + (lane & 31)]; }
    LDS_WAIT(); asm volatile("" ::: "memory");
    const int c = lane & 7;
#pragma unroll
    for (int j = 0; j < 4; ++j) { const int n = (lane >> 3) + 8 * j; const LAS float* s = scr + (8 * c) * 33 + n;
        u32x4 o; o.x = cvt_pk_bf16(s[0 * 33], s[1 * 33]); o.y = cvt_pk_bf16(s[2 * 33], s[3 * 33]); o.z = cvt_pk_bf16(s[4 * 33], s[5 * 33]); o.w = cvt_pk_bf16(s[6 * 33], s[7 * 33]);
        *(u32x4*)(WT + (size_t)(drow0 + n) * K + k0 + 8 * c) = o; }
    LDS_WAIT(); asm volatile("" ::: "memory");
}
DI void conv_job(const float* W, int K, int N, bf16_t* T, bf16_t* T2, int mode, int item, LAS float* scr, int lane) {
    const int nblk = N / 32, kb = item / nblk, nb = item - kb * nblk, k0 = 64 * kb, n0 = 32 * nb;
    int drow0 = n0; bf16_t* dst = T;
    if (mode == 1) drow0 = (n0 >> 7) * 256 + (n0 & 127);
    else if (mode == 2) drow0 = (n0 >> 7) * 256 + 128 + (n0 & 127);
    else if (mode == 3) { if (n0 >= 2048) { dst = T2; drow0 = n0 - 2048; } }
    transpose_item(W, N, dst, K, k0, n0, drow0, scr, lane);
}

struct Params { const float* in[23]; float* out; unsigned char* ws; int ph_lo, ph_hi; };

DI void phase0(const Params& P, LAS unsigned char* lds, int vcu, int G) {
    const int tid = threadIdx.x, lane = tid & 63, wave = __builtin_amdgcn_readfirstlane(tid >> 6);
    unsigned char* ws = P.ws;
    LAS float* S = (LAS float*)(lds + 70000);
    for (int i = tid; i < 5 * 1024; i += 512) { const int m = i >> 10, k = i & 1023; const float v = m < 4 ? P.in[1][m * 1024 + k] : P.in[3][k]; S[i] = silu_f(v); }
    __syncthreads();
    float* MOD = (float*)(ws + WS_MOD);
    LAS float* RED = (LAS float*)(lds + 96000);
    for (int it = blockIdx.x; it < 192; it += G) {
        const int l = it / 96, n = (it - l * 96) * 64 + (tid & 63), ksl = tid >> 6;
        const float* w = P.in[4] + (size_t)l * 1024 * 6144 + (size_t)(ksl * 128) * 6144 + n;
        float a0 = 0.f, a1 = 0.f, a2 = 0.f, a3 = 0.f, a4 = 0.f;
#pragma unroll 16
        for (int k = 0; k < 128; ++k) { const float wv = w[(size_t)k * 6144]; const int kk = ksl * 128 + k;
            a0 += S[kk] * wv; a1 += S[1024 + kk] * wv; a2 += S[2048 + kk] * wv; a3 += S[3072 + kk] * wv; a4 += S[4096 + kk] * wv; }
        __syncthreads();
        RED[(ksl * 5 + 0) * 64 + (tid & 63)] = a0; RED[(ksl * 5 + 1) * 64 + (tid & 63)] = a1; RED[(ksl * 5 + 2) * 64 + (tid & 63)] = a2; RED[(ksl * 5 + 3) * 64 + (tid & 63)] = a3; RED[(ksl * 5 + 4) * 64 + (tid & 63)] = a4;
        __syncthreads();
        if (tid < 320) { const int m = tid >> 6, c = tid & 63; float sum = P.in[5][l * 6144 + (it - l * 96) * 64 + c];
#pragma unroll
            for (int q = 0; q < 8; ++q) sum += RED[(q * 5 + m) * 64 + c];
            MOD[(size_t)l * 5 * 6144 + m * 6144 + (it - l * 96) * 64 + c] = sum; }
    }
    if (blockIdx.x == 0) {
        float* rope = (float*)(ws + WS_ROPE);
        for (int i = tid; i < 1024; i += 512) { const int pos = i >> 4, f = i & 15; const float inv = powf(10000.0f, -(float)f / 16.0f); const float ang = (float)pos * inv;
            rope[i] = cosf(ang); rope[1024 + i] = sinf(ang); }
    }
    { bf16_t* wx = (bf16_t*)(ws + WS_WXBC); const int total = (NXBCP - 4160) * 1024 / 8;
      for (int i = blockIdx.x * 512 + tid; i < total; i += G * 512) *(u32x4*)(wx + (size_t)4160 * 1024 + (size_t)i * 8) = (u32x4){0u, 0u, 0u, 0u}; }
    LAS float* scr = (LAS float*)(lds + wave * 8448);
    const int gw = vcu * 8 + wave, NGW = G * 8;
    constexpr int I_QKV = 16 * 48, I_WO = 16 * 32, I_G = 16 * 88, I_D = 44 * 32, I_IN = 16 * 194, I_OUT = 32 * 32;
    constexpr int NIT = I_QKV + I_WO + 2 * I_G + I_D + I_IN + I_OUT;
    for (int it = gw; it < NIT; it += NGW) {
        int r = it;
        if (r < I_QKV) { conv_job(P.in[8], 1024, 1536, (bf16_t*)(ws + WS_WQKV), nullptr, 0, r, scr, lane); continue; } r -= I_QKV;
        if (r < I_WO) { conv_job(P.in[9], 1024, 1024, (bf16_t*)(ws + WS_WO), nullptr, 0, r, scr, lane); continue; } r -= I_WO;
        if (r < I_G) { conv_job(P.in[19], 1024, DFF, (bf16_t*)(ws + WS_GU0), nullptr, 1, r, scr, lane); continue; } r -= I_G;
        if (r < I_G) { conv_job(P.in[20], 1024, DFF, (bf16_t*)(ws + WS_GU0), nullptr, 2, r, scr, lane); continue; } r -= I_G;
        if (r < I_D) { conv_job(P.in[21], DFF, 1024, (bf16_t*)(ws + WS_DN0), nullptr, 0, r, scr, lane); continue; } r -= I_D;
        if (r < I_IN) { conv_job(P.in[11], 1024, 6208, (bf16_t*)(ws + WS_WZ), (bf16_t*)(ws + WS_WXBC), 3, r, scr, lane); continue; } r -= I_IN;
        conv_job(P.in[18], DIN, 1024, (bf16_t*)(ws + WS_WOUT), nullptr, 0, r, scr, lane);
    }
}

DI void phase_conv_ffn1(const Params& P, LAS unsigned char* lds, int vcu, int G) {
    const int tid = threadIdx.x, lane = tid & 63, wave = __builtin_amdgcn_readfirstlane(tid >> 6);
    unsigned char* ws = P.ws;
    LAS float* scr = (LAS float*)(lds + wave * 8448);
    const int gw = vcu * 8 + wave, NGW = G * 8;
    constexpr int I_G = 16 * 88, I_D = 44 * 32, NIT = 2 * I_G + I_D;
    const size_t o1 = (size_t)1024 * DFF;
    for (int it = gw; it < NIT; it += NGW) {
        int r = it;
        if (r < I_G) { conv_job(P.in[19] + o1, 1024, DFF, (bf16_t*)(ws + WS_GU1), nullptr, 1, r, scr, lane); continue; } r -= I_G;
        if (r < I_G) { conv_job(P.in[20] + o1, 1024, DFF, (bf16_t*)(ws + WS_GU1), nullptr, 2, r, scr, lane); continue; } r -= I_G;
        conv_job(P.in[21] + o1, DFF, 1024, (bf16_t*)(ws + WS_DN1), nullptr, 0, r, scr, lane);
    }
}

struct CtxPart { const float* pA; const float* pB; const float* gate; float* ctx_out; int ns; };
DI void norm_phase(const float* xL, const float* xC, const float* g, const float* mod, int shoff, int scoff, bf16_t* HN, int nrows, int gw, int NGW, int lane, const CtxPart cp) {
    for (int row = gw; row < nrows; row += NGW) {
        const float* src = row < ML ? xL + (size_t)row * 1024 : xC + (size_t)(row - ML) * 1024; const int m = row < ML ? (row >> 12) : 4;
        f32x4 v[4]; float ss = 0.f;
#pragma unroll
        for (int j = 0; j < 4; ++j) v[j] = *(const f32x4*)(src + 4 * lane + 256 * j);
        if (row >= ML && cp.ns > 0) {
            const size_t ro = (size_t)(row - ML) * 1024;
#pragma unroll
            for (int j = 0; j < 4; ++j) { const int col = 4 * lane + 256 * j; f32x4 acc4 = (f32x4){0.f, 0.f, 0.f, 0.f};
                for (int k = 0; k < cp.ns; ++k) { const float* pp = (k < 10 ? cp.pA + (size_t)k * MC * 1024 : cp.pB) + ro + col; acc4 += *(const f32x4*)pp; }
                v[j] += *(const f32x4*)(cp.gate + col) * acc4; *(f32x4*)(cp.ctx_out + ro + col) = v[j]; }
        }
#pragma unroll
        for (int j = 0; j < 4; ++j) ss += (v[j].x * v[j].x + v[j].y * v[j].y) + (v[j].z * v[j].z + v[j].w * v[j].w);
        const float rstd = 1.0f / sqrtf(wave_sum(ss) * (1.0f / 1024.0f) + EPS);
#pragma unroll
        for (int j = 0; j < 4; ++j) { const int col = 4 * lane + 256 * j;
            const f32x4 g4 = *(const f32x4*)(g + col), sc = *(const f32x4*)(mod + m * 6144 + scoff + col), sh = *(const f32x4*)(mod + m * 6144 + shoff + col);
            const f32x4 o = (v[j] * rstd * g4) * (sc + 1.0f) + sh;
            u32x2 w; w.x = cvt_pk_bf16(o[0], o[1]); w.y = cvt_pk_bf16(o[2], o[3]); *(u32x2*)(HN + (size_t)row * 1024 + col) = w; }
    }
}
DI void final_norm_phase(float* x, const float* g, int gw, int NGW, int lane) {
    for (int row0 = gw; row0 < ML; row0 += 2 * NGW) {
        const int row1 = row0 + NGW; const bool has1 = row1 < ML; const int r1 = has1 ? row1 : row0;
        float* s0 = x + (size_t)row0 * 1024; float* s1 = x + (size_t)r1 * 1024; f32x4 v0[4], v1[4]; float ss0 = 0.f, ss1 = 0.f;
#pragma unroll
        for (int j = 0; j < 4; ++j) { v0[j] = *(const f32x4*)(s0 + 4 * lane + 256 * j); v1[j] = *(const f32x4*)(s1 + 4 * lane + 256 * j); }
#pragma unroll
        for (int j = 0; j < 4; ++j) { ss0 += (v0[j].x * v0[j].x + v0[j].y * v0[j].y) + (v0[j].z * v0[j].z + v0[j].w * v0[j].w); ss1 += (v1[j].x * v1[j].x + v1[j].y * v1[j].y) + (v1[j].z * v1[j].z + v1[j].w * v1[j].w); }
#pragma unroll
        for (int o = 1; o < 64; o <<= 1) { ss0 += __shfl_xor(ss0, o); ss1 += __shfl_xor(ss1, o); }
        const float rstd0 = 1.0f / sqrtf(ss0 * (1.0f / 1024.0f) + EPS), rstd1 = 1.0f / sqrtf(ss1 * (1.0f / 1024.0f) + EPS);
#pragma unroll
        for (int j = 0; j < 4; ++j) { const int col = 4 * lane + 256 * j; const f32x4 g4 = *(const f32x4*)(g + col);
            *(f32x4*)(s0 + col) = v0[j] * rstd0 * g4; if (has1) *(f32x4*)(s1 + col) = v1[j] * rstd1 * g4; }
    }
}
DI void gnorm_phase(bf16_t* Y, const float* SSQ, const float* ng, int G) {
    const int total = ML * 256;
    for (int i = blockIdx.x * 512 + threadIdx.x; i < total; i += G * 512) {
        const int row = i >> 8, col = (i & 255) * 8; const float rstd = 1.0f / sqrtf(SSQ[(size_t)row * 8 + (col >> 8)] * (1.0f / 256.0f) + EPS);
        bf16_t* p = Y + (size_t)row * DIN + col; const u32x4 v = *(const u32x4*)p; const f32x4 g0 = *(const f32x4*)(ng + col), g1 = *(const f32x4*)(ng + col + 4);
        u32x4 w; w.x = cvt_pk_bf16(bflo(v.x) * rstd * g0[0], bfhi(v.x) * rstd * g0[1]); w.y = cvt_pk_bf16(bflo(v.y) * rstd * g0[2], bfhi(v.y) * rstd * g0[3]);
        w.z = cvt_pk_bf16(bflo(v.z) * rstd * g1[0], bfhi(v.z) * rstd * g1[1]); w.w = cvt_pk_bf16(bflo(v.w) * rstd * g1[2], bfhi(v.w) * rstd * g1[3]);
        *(u32x4*)p = w;
    }
}

#define MFMA32(a, b, c) __builtin_amdgcn_mfma_f32_32x32x16_bf16((a), (b), (c), 0, 0, 0)
#define MFMA16(a, b, c) __builtin_amdgcn_mfma_f32_16x16x32_bf16((a), (b), (c), 0, 0, 0)
DI int crow(int r, int hi) { return (r & 3) + 8 * (r >> 2) + 4 * hi; }
DI bf16x8 pack8(float a0, float a1, float a2, float a3, float a4, float a5, float a6, float a7) {
    u32x4 p; p.x = cvt_pk_bf16(a0, a1); p.y = cvt_pk_bf16(a2, a3); p.z = cvt_pk_bf16(a4, a5); p.w = cvt_pk_bf16(a6, a7); return __builtin_bit_cast(bf16x8, p);
}
DI void attn_phase(LAS unsigned char* lds, const bf16_t* Q, bf16_t* O, const bf16_t* Kb, const bf16_t* VT, const float* sinks, int vcu, int G) {
    const int tid = threadIdx.x, lane = tid & 63, w = __builtin_amdgcn_readfirstlane(tid >> 6), r = lane & 31, h = lane >> 5;
    constexpr int KST = 144, VST = 1168, KBYTES = 576 * KST;
    LAS unsigned char* Ks = lds; LAS unsigned char* Vs = lds + KBYTES;
    for (int u = vcu; u < 1088; u += G) {
        int b, g, q0, nk; bool isctx;
        if (u < 1024) { b = u >> 8; g = (u >> 6) & 3; q0 = (u & 63) * 64; nk = 576; isctx = false; }
        else { const int uc = u - 1024; b = uc >> 4; g = (uc >> 2) & 3; q0 = (uc & 3) * 64; nk = 256; isctx = true; }
#pragma unroll 3
        for (int c = tid; c < nk * 8; c += 512) {
            const int s = c >> 3, part = c & 7; size_t grow; bool ok = true;
            if (s < 256) grow = (size_t)ML + b * 256 + s; else { const int pos = q0 - 128 + (s - 256); ok = pos >= 0 && pos < SEQ; grow = (size_t)b * SEQ + pos; }
            u32x4 v = (u32x4){0u, 0u, 0u, 0u}; if (ok) v = *(const u32x4*)(Kb + grow * 256 + g * 64 + part * 8);
            *(LAS u32x4*)(Ks + s * KST + part * 16) = v;
        }
        const int cpr = nk >> 3;
#pragma unroll 3
        for (int c = tid; c < 64 * cpr; c += 512) {
            const int d = c / cpr, s = (c - d * cpr) * 8; int pos; bool ok = true;
            if (s < 256) pos = 4096 + s; else { pos = q0 - 128 + (s - 256); ok = pos >= 0 && pos < SEQ; }
            u32x4 v = (u32x4){0u, 0u, 0u, 0u}; if (ok) v = *(const u32x4*)(VT + (size_t)((b * 4 + g) * 64 + d) * VTP + pos);
            *(LAS u32x4*)(Vs + d * VST + s * 2) = v;
        }
        const int hq = g * 4 + (w >> 1), ql = 32 * (w & 1) + r;
        const size_t qrow = (isctx ? (size_t)ML + b * 256 : (size_t)b * SEQ) + q0 + ql;
        bf16x8 qf[4];
#pragma unroll
        for (int d0 = 0; d0 < 4; ++d0) qf[d0] = *(const bf16x8*)(Q + qrow * 1024 + hq * 64 + d0 * 16 + h * 8);
        __syncthreads();
        float m_run = sinks[hq] * LOG2E, l_run = (h == 0) ? 1.f : 0.f;
        f32x16 o0, o1;
#pragma unroll
        for (int i = 0; i < 16; ++i) { o0[i] = 0.f; o1[i] = 0.f; }
        const int qpos = q0 + ql, ntile = nk >> 6;
        for (int kt = 0; kt < ntile; ++kt) {
            f32x16 p0, p1;
#pragma unroll
            for (int i = 0; i < 16; ++i) { p0[i] = 0.f; p1[i] = 0.f; }
            const LAS unsigned char* kb = Ks + (kt * 64 + r) * KST + h * 16;
#pragma unroll
            for (int d0 = 0; d0 < 4; ++d0) {
                const bf16x8 a0 = *(const LAS bf16x8*)(kb + d0 * 32), a1 = *(const LAS bf16x8*)(kb + 32 * KST + d0 * 32);
                p0 = MFMA32(a0, qf[d0], p0); p1 = MFMA32(a1, qf[d0], p1);
            }
            const int pbase_u = q0 - 128 + (kt - 4) * 64;
            if (kt >= 4 && (kt == 4 || kt == 8 || pbase_u < 0 || pbase_u + 64 > SEQ)) {
                const int pbase = pbase_u;
#pragma unroll
                for (int i = 0; i < 16; ++i) {
                    const int k0 = pbase + crow(i, h), k1 = k0 + 32; const int d0 = k0 - qpos, d1 = k1 - qpos;
                    const bool v0 = k0 >= 0 && k0 < SEQ && d0 <= 128 && d0 >= -128, v1 = k1 >= 0 && k1 < SEQ && d1 <= 128 && d1 >= -128;
                    if (!v0) p0[i] = -INFINITY; if (!v1) p1[i] = -INFINITY;
                }
            }
            float mt = p0[0];
#pragma unroll
            for (int i = 1; i < 16; ++i) mt = fmaxf(mt, p0[i]);
#pragma unroll
            for (int i = 0; i < 16; ++i) mt = fmaxf(mt, p1[i]);
            mt = fmaxf(mt, __shfl_xor(mt, 32));
            const float mn = fmaxf(m_run, mt), alpha = __builtin_amdgcn_exp2f(m_run - mn); m_run = mn;
            float ls = 0.f;
#pragma unroll
            for (int i = 0; i < 16; ++i) { p0[i] = __builtin_amdgcn_exp2f(p0[i] - mn); ls += p0[i]; p1[i] = __builtin_amdgcn_exp2f(p1[i] - mn); ls += p1[i]; }
            l_run = l_run * alpha + ls;
            if (__any(alpha != 1.0f)) {
#pragma unroll
                for (int i = 0; i < 16; ++i) { o0[i] *= alpha; o1[i] *= alpha; }
            }
#pragma unroll
            for (int hf = 0; hf < 2; ++hf)
#pragma unroll
                for (int s = 0; s < 2; ++s) {
                    const bf16x8 pb = hf == 0 ? pack8(p0[8 * s], p0[8 * s + 1], p0[8 * s + 2], p0[8 * s + 3], p0[8 * s + 4], p0[8 * s + 5], p0[8 * s + 6], p0[8 * s + 7])
                                              : pack8(p1[8 * s], p1[8 * s + 1], p1[8 * s + 2], p1[8 * s + 3], p1[8 * s + 4], p1[8 * s + 5], p1[8 * s + 6], p1[8 * s + 7]);
                    const int kk = kt * 64 + 32 * hf + 16 * s + 4 * h;
                    { const LAS unsigned char* vp = Vs + r * VST + kk * 2; const s16x4 lo = *(const LAS s16x4*)vp, hi = *(const LAS s16x4*)(vp + 16);
                      o0 = MFMA32(__builtin_shufflevector(lo, hi, 0, 1, 2, 3, 4, 5, 6, 7), pb, o0); }
                    { const LAS unsigned char* vp = Vs + (32 + r) * VST + kk * 2; const s16x4 lo = *(const LAS s16x4*)vp, hi = *(const LAS s16x4*)(vp + 16);
                      o1 = MFMA32(__builtin_shufflevector(lo, hi, 0, 1, 2, 3, 4, 5, 6, 7), pb, o1); }
                }
        }
        const float inv = 1.0f / (l_run + __shfl_xor(l_run, 32));
        bf16_t* op = O + qrow * 1024 + hq * 64 + 4 * h;
#pragma unroll
        for (int gi = 0; gi < 4; ++gi) {
            u32x2 a; a.x = cvt_pk_bf16(o0[4 * gi] * inv, o0[4 * gi + 1] * inv); a.y = cvt_pk_bf16(o0[4 * gi + 2] * inv, o0[4 * gi + 3] * inv); *(u32x2*)(op + 8 * gi) = a;
            u32x2 c; c.x = cvt_pk_bf16(o1[4 * gi] * inv, o1[4 * gi + 1] * inv); c.y = cvt_pk_bf16(o1[4 * gi + 2] * inv, o1[4 * gi + 3] * inv); *(u32x2*)(op + 32 + 8 * gi) = c;
        }
        __syncthreads();
    }
}

typedef short v4i16_t __attribute__((ext_vector_type(4)));
DI s16x4 tr4(const LAS unsigned char* p) { return __builtin_bit_cast(s16x4, __builtin_amdgcn_ds_read_tr16_b64_v4i16((LAS v4i16_t*)p)); }
constexpr int S_BM = 0, S_CM = 34816, S_XS = 69632, S_XW = 79872, S_HB = 90112, S_AR = 98816, AR_BYTES = 4160, S_CW = S_AR + 2 * AR_BYTES;
struct CW8 { float w0[8], w1[8], w2[8], bs[8]; };
DI void cw_load(CW8& c, const LAS float* cw) {
    *(f32x4*)&c.w0[0] = *(const LAS f32x4*)(cw); *(f32x4*)&c.w0[4] = *(const LAS f32x4*)(cw + 4);
    *(f32x4*)&c.w1[0] = *(const LAS f32x4*)(cw + 8); *(f32x4*)&c.w1[4] = *(const LAS f32x4*)(cw + 12);
    *(f32x4*)&c.w2[0] = *(const LAS f32x4*)(cw + 16); *(f32x4*)&c.w2[4] = *(const LAS f32x4*)(cw + 20);
    *(f32x4*)&c.bs[0] = *(const LAS f32x4*)(cw + 24); *(f32x4*)&c.bs[4] = *(const LAS f32x4*)(cw + 28);
}
DI void conv8(const u32x4& vm, const u32x4& v0, const u32x4& vp, const CW8& c, float* o) {
    const unsigned am[4] = {vm.x, vm.y, vm.z, vm.w}, a0[4] = {v0.x, v0.y, v0.z, v0.w}, ap[4] = {vp.x, vp.y, vp.z, vp.w};
#pragma unroll
    for (int e = 0; e < 4; ++e) {
        const float lo = c.bs[2 * e] + c.w0[2 * e] * bflo(am[e]) + c.w1[2 * e] * bflo(a0[e]) + c.w2[2 * e] * bflo(ap[e]);
        const float hi = c.bs[2 * e + 1] + c.w0[2 * e + 1] * bfhi(am[e]) + c.w1[2 * e + 1] * bfhi(a0[e]) + c.w2[2 * e + 1] * bfhi(ap[e]);
        o[2 * e] = silu_f(lo); o[2 * e + 1] = silu_f(hi);
    }
}

constexpr int CV_SEG = 16, CV_ITEMS = (MT / CV_SEG) * 8, CV_MAXK = 5;
struct ConvHalo { u32x4 top[CV_MAXK], bot[CV_MAXK]; };
DI void conv_bounds(int r0, int& lo, int& hi) { if (r0 < ML) { lo = r0 & ~4095; hi = lo + SEQ; } else { lo = ML + ((r0 - ML) & ~255); hi = lo + CTXL; } }
DI void conv_capture(ConvHalo& hh, const bf16_t* X, int gw, int NGW, int lane) {
#pragma unroll
    for (int k = 0; k < CV_MAXK; ++k) {
        const int item = gw + k * NGW; hh.top[k] = (u32x4){0u, 0u, 0u, 0u}; hh.bot[k] = hh.top[k];
        if (item < CV_ITEMS) { const int r0 = (item >> 3) * CV_SEG, ch = (item & 7) * 512 + lane * 8; int lo, hi; conv_bounds(r0, lo, hi);
            if (r0 > lo) hh.top[k] = *(const u32x4*)(X + (size_t)(r0 - 1) * NXBC + ch);
            if (r0 + CV_SEG < hi) hh.bot[k] = *(const u32x4*)(X + (size_t)(r0 + CV_SEG) * NXBC + ch); }
    }
}
DI void conv_apply(const ConvHalo& hh, bf16_t* X, const float* conv_w, const float* conv_b, int gw, int NGW, int lane) {
#pragma unroll
    for (int k = 0; k < CV_MAXK; ++k) {
        const int item = gw + k * NGW;
        if (item < CV_ITEMS) {
            const int r0 = (item >> 3) * CV_SEG, ch = (item & 7) * 512 + lane * 8;
            bf16_t* xp = X + (size_t)r0 * NXBC + ch;
            u32x4 rows[CV_SEG + 2]; rows[0] = hh.top[k]; rows[CV_SEG + 1] = hh.bot[k];
#pragma unroll
            for (int t = 0; t < CV_SEG; ++t) rows[t + 1] = *(const u32x4*)(xp + (size_t)t * NXBC);
            CW8 c;
            *(f32x4*)&c.w0[0] = *(const f32x4*)(conv_w + ch); *(f32x4*)&c.w0[4] = *(const f32x4*)(conv_w + ch + 4);
            *(f32x4*)&c.w1[0] = *(const f32x4*)(conv_w + 4096 + ch); *(f32x4*)&c.w1[4] = *(const f32x4*)(conv_w + 4096 + ch + 4);
            *(f32x4*)&c.w2[0] = *(const f32x4*)(conv_w + 8192 + ch); *(f32x4*)&c.w2[4] = *(const f32x4*)(conv_w + 8192 + ch + 4);
            *(f32x4*)&c.bs[0] = *(const f32x4*)(conv_b + ch); *(f32x4*)&c.bs[4] = *(const f32x4*)(conv_b + ch + 4);
#pragma unroll
            for (int t = 0; t < CV_SEG; ++t) { float o[8]; conv8(rows[t], rows[t + 1], rows[t + 2], c, o);
                u32x4 pk; pk.x = cvt_pk_bf16(o[0], o[1]); pk.y = cvt_pk_bf16(o[2], o[3]); pk.z = cvt_pk_bf16(o[4], o[5]); pk.w = cvt_pk_bf16(o[6], o[7]);
                *(u32x4*)(xp + (size_t)t * NXBC) = pk; }
        }
    }
}
DI void ssd_chunk(int b, int dir, int st, int& row0, int& seq_lo, int& seq_hi, bool& lat) {
    if (st < 2) { const int c = dir ? 1 - st : st; seq_lo = ML + b * 256; seq_hi = seq_lo + 256; row0 = seq_lo + 128 * c; lat = false; }
    else { const int ck = dir ? 33 - st : st - 2; seq_lo = b * SEQ; seq_hi = seq_lo + SEQ; row0 = seq_lo + 128 * ck; lat = true; }
}
DI u32x4 ld_row(const bf16_t* XBC, int grow, int seq_lo, int seq_hi, int ch) {
    u32x4 v = (u32x4){0u, 0u, 0u, 0u}; if (grow >= seq_lo && grow < seq_hi) v = *(const u32x4*)(XBC + (size_t)grow * NXBC + ch); return v;
}
DI void ssd_scan(LAS float* AR, int w, int lane, int dir, float d0, float d1, float A) {
    const int t0 = 2 * lane; const float a0 = d0 * A, a1 = d1 * A, s2 = a0 + a1; float incl = s2;
#pragma unroll
    for (int o = 1; o < 64; o <<= 1) { const float v = __shfl_up(incl, o); if (lane >= o) incl += v; }
    const float tot = __shfl(incl, 63);
    if (w == 0) {
        const float c0 = incl - s2 + a0, c1 = incl;
        const float cr = __shfl(c1, (lane & ~7) | 7);
        *(LAS f32x2*)(AR + t0) = (f32x2){c0, c1}; *(LAS f32x2*)(AR + 256 + t0) = (f32x2){d0, d1};
        *(LAS f32x2*)(AR + 768 + t0) = (f32x2){__expf(cr - c0) * d0, __expf(cr - c1) * d1};
        if (dir == 0) { *(LAS f32x2*)(AR + 512 + t0) = (f32x2){__expf(tot - c0) * d0, __expf(tot - c1) * d1}; *(LAS f32x2*)(AR + 640 + t0) = (f32x2){__expf(c0), __expf(c1)}; if (lane == 0) AR[1024] = __expf(tot); }
    } else {
        const float c0 = tot - (incl - s2), c1 = c0 - a0;
        const float cr = __shfl(c0, lane & ~7);
        *(LAS f32x2*)(AR + 128 + t0) = (f32x2){c0, c1}; *(LAS f32x2*)(AR + 384 + t0) = (f32x2){d0, d1};
        *(LAS f32x2*)(AR + 896 + t0) = (f32x2){__expf(cr - c0) * d0, __expf(cr - c1) * d1};
        if (dir == 1) { *(LAS f32x2*)(AR + 512 + t0) = (f32x2){__expf(tot - c0) * d0, __expf(tot - c1) * d1}; *(LAS f32x2*)(AR + 640 + t0) = (f32x2){__expf(c0), __expf(c1)}; if (lane == 0) AR[1024] = __expf(tot); }
    }
}
DI void ssd_phase(LAS unsigned char* lds, const bf16_t* XBC, const float* DT, bf16_t* Y, const float* conv_w, const float* conv_b, const float* A_log, const float* Dsk, int vcu, int G) {
    const int tid = threadIdx.x, lane = tid & 63, w = __builtin_amdgcn_readfirstlane(tid >> 6), fr = lane & 15, fq = lane >> 4, qq = (lane & 15) >> 2, pp = lane & 3;
    const int chgrp = tid & 15, rb = tid >> 4, chg = tid & 3, tx = tid >> 2;
    for (int u = vcu; u < 256; u += G) {
        const int b = u >> 6, g = (u >> 3) & 7, hd = g * 4 + ((u >> 1) & 3), ph = u & 1;
        const float Af = -__expf(A_log[hd]), Ab = -__expf(A_log[32 + hd]), Dv = Dsk[hd];
        const int xch = hd * 64 + ph * 32;
        const int chB = 2048 + g * 128 + chgrp * 8, chC = chB + 1024, chX = xch + chg * 8;
        __syncthreads();
        for (int dir = 0; dir < 2; ++dir) {
            f32x4 H[2]; H[0] = (f32x4){0.f, 0.f, 0.f, 0.f}; H[1] = H[0];
            const float Aw = w == 0 ? Af : Ab; const int dcol = (w == 0 ? 0 : 32) + hd;
            int row0, seq_lo, seq_hi; bool lat;
            ssd_chunk(b, dir, 0, row0, seq_lo, seq_hi, lat);
            u32x4 vB[4], vC[4], vX; u32x2 yold[2]; yold[0] = (u32x2){0u, 0u}; yold[1] = yold[0];
            u32x2 ypend[2]; ypend[0] = yold[0]; ypend[1] = yold[0]; bf16_t* ypp = nullptr;
#pragma unroll
            for (int q = 0; q < 4; ++q) { vB[q] = *(const u32x4*)(XBC + (size_t)(row0 + 4 * rb + q) * NXBC + chB); vC[q] = *(const u32x4*)(XBC + (size_t)(row0 + 4 * rb + q) * NXBC + chC); }
            vX = *(const u32x4*)(XBC + (size_t)(row0 + tx) * NXBC + chX);
            __syncthreads();
            if (w < 2) { const float* dp = DT + (size_t)(row0 + 2 * lane) * 64 + dcol; ssd_scan((LAS float*)(lds + S_AR), w, lane, dir, dp[0], dp[64], Aw); }
            for (int st = 0; st < 34; ++st) {
                LAS float* AR = (LAS float*)(lds + S_AR + (st & 1) * AR_BYTES);
                LAS float* CF = AR; LAS float* CBK = AR + 128; LAS float* DTF = AR + 256; LAS float* DTB = AR + 384; LAS float* WST = AR + 512; LAS float* ECUM = AR + 640;
                const bool need_diag = lat && dir == 0; const bool curlat = lat; const int currow0 = row0;
                __syncthreads();
#pragma unroll
                for (int pt = 0; pt < 2; ++pt)
#pragma unroll
                    for (int jj = 0; jj < 4; ++jj) *(LAS bf16_t*)(lds + S_HB + (16 * pt + 4 * fq + jj) * 272 + (16 * w + fr) * 2) = (bf16_t)(cvt_pk_bf16(H[pt][jj], 0.f) & 0xffffu);
                const float ws_ = WST[tx];
#pragma unroll
                for (int q = 0; q < 4; ++q) { *(LAS u32x4*)(lds + S_BM + (4 * rb + q) * 272 + chgrp * 16) = vB[q]; *(LAS u32x4*)(lds + S_CM + (4 * rb + q) * 272 + chgrp * 16) = vC[q]; }
                { *(LAS u32x4*)(lds + S_XS + tx * 80 + chg * 16) = vX;
                    u32x4 pk; pk.x = cvt_pk_bf16(bflo(vX.x) * ws_, bfhi(vX.x) * ws_); pk.y = cvt_pk_bf16(bflo(vX.y) * ws_, bfhi(vX.y) * ws_);
                    pk.z = cvt_pk_bf16(bflo(vX.z) * ws_, bfhi(vX.z) * ws_); pk.w = cvt_pk_bf16(bflo(vX.w) * ws_, bfhi(vX.w) * ws_);
                    *(LAS u32x4*)(lds + S_XW + tx * 80 + chg * 16) = pk; }
                __syncthreads();
                const int il = 16 * w + fr;
                const u32x2 ycur0 = yold[0], ycur1 = yold[1];
                float dn0 = 0.f, dn1 = 0.f;
                if (ypp) { *(u32x2*)ypp = ypend[0]; *(u32x2*)(ypp + 16) = ypend[1]; ypp = nullptr; }
                if (st + 1 < 34) {
                    ssd_chunk(b, dir, st + 1, row0, seq_lo, seq_hi, lat);
#pragma unroll
                    for (int q = 0; q < 4; ++q) { vB[q] = *(const u32x4*)(XBC + (size_t)(row0 + 4 * rb + q) * NXBC + chB); vC[q] = *(const u32x4*)(XBC + (size_t)(row0 + 4 * rb + q) * NXBC + chC); }
                    vX = *(const u32x4*)(XBC + (size_t)(row0 + tx) * NXBC + chX);
                    if (w < 2) { const float* dp = DT + (size_t)(row0 + 2 * lane) * 64 + dcol; dn0 = dp[0]; dn1 = dp[64]; }
                    if (dir == 1 && lat) { const bf16_t* yp = Y + (size_t)(row0 + il) * DIN + xch + 4 * fq; yold[0] = *(const u32x2*)yp; yold[1] = *(const u32x2*)(yp + 16); }
                }
                bf16x8 cfr[4];
#pragma unroll
                for (int ks = 0; ks < 4; ++ks) cfr[ks] = *(const LAS bf16x8*)(lds + S_CM + il * 272 + (32 * ks + 8 * fq) * 2);
                f32x4 yacc[2]; yacc[0] = (f32x4){0.f, 0.f, 0.f, 0.f}; yacc[1] = yacc[0];
                if (need_diag) {
                    const float cfi = CF[il], cbi = CBK[il];
                    bf16x8 mfr[4];
                    f32x4 ga[8];
#pragma unroll
                    for (int jt = 0; jt < 8; ++jt) ga[jt] = (f32x4){0.f, 0.f, 0.f, 0.f};
#pragma unroll
                    for (int ks = 0; ks < 4; ++ks) {
                        bf16x8 bfr[8];
#pragma unroll
                        for (int jt = 0; jt < 8; ++jt) bfr[jt] = *(const LAS bf16x8*)(lds + S_BM + (16 * jt + fr) * 272 + (32 * ks + 8 * fq) * 2);
#pragma unroll
                        for (int jt = 0; jt < 8; ++jt) ga[jt] = MFMA16(bfr[jt], cfr[ks], ga[jt]);
                    }
                    LAS float* E2F = AR + 768; LAS float* E2B = AR + 896;
#pragma unroll
                    for (int uu = 0; uu < 4; ++uu) {
                        float val[8];
#pragma unroll
                        for (int hf = 0; hf < 2; ++hf) {
                            const int jt = 2 * uu + hf;
                            const int j0 = 16 * jt + 4 * fq;
                            if (jt < w) {
                                const float e1 = __expf(cfi - CF[16 * jt + 15]); const f32x4 e2 = *(const LAS f32x4*)(E2F + j0);
#pragma unroll
                                for (int jj = 0; jj < 4; ++jj) val[hf * 4 + jj] = ga[jt][jj] * (e1 * e2[jj]);
                            } else if (jt > w) {
                                const float e1 = __expf(cbi - CBK[16 * jt]); const f32x4 e2 = *(const LAS f32x4*)(E2B + j0);
#pragma unroll
                                for (int jj = 0; jj < 4; ++jj) val[hf * 4 + jj] = ga[jt][jj] * (e1 * e2[jj]);
                            } else {
                                const f32x4 cfj = *(const LAS f32x4*)(CF + j0), cbj = *(const LAS f32x4*)(CBK + j0), dfj = *(const LAS f32x4*)(DTF + j0), dbj = *(const LAS f32x4*)(DTB + j0);
#pragma unroll
                                for (int jj = 0; jj < 4; ++jj) { const int j = j0 + jj;
                                    const float mf = (j <= il) ? __expf(fminf(cfi - cfj[jj], 0.f)) * dfj[jj] : 0.f;
                                    const float mb = (j >= il) ? __expf(fminf(cbi - cbj[jj], 0.f)) * dbj[jj] : 0.f;
                                    val[hf * 4 + jj] = ga[jt][jj] * (mf + mb); }
                            }
                        }
                        mfr[uu] = pack8(val[0], val[1], val[2], val[3], val[4], val[5], val[6], val[7]);
                    }
                    bf16x8 xfr[2][4];
#pragma unroll
                    for (int pt = 0; pt < 2; ++pt)
#pragma unroll
                        for (int uu = 0; uu < 4; ++uu) {
                            const s16x4 lo = tr4(lds + S_XS + (32 * uu + 4 * fq + qq) * 80 + pt * 32 + pp * 8), hi = tr4(lds + S_XS + (32 * uu + 16 + 4 * fq + qq) * 80 + pt * 32 + pp * 8);
                            xfr[pt][uu] = __builtin_shufflevector(lo, hi, 0, 1, 2, 3, 4, 5, 6, 7);
                        }
#pragma unroll
                    for (int uu = 0; uu < 4; ++uu)
#pragma unroll
                        for (int pt = 0; pt < 2; ++pt) yacc[pt] = MFMA16(xfr[pt][uu], mfr[uu], yacc[pt]);
                }
                if (curlat) {
                    const float ec = ECUM[il];
#pragma unroll
                    for (int pt = 0; pt < 2; ++pt) {
                        f32x4 oa = (f32x4){0.f, 0.f, 0.f, 0.f};
                        bf16x8 hfr[4];
#pragma unroll
                        for (int ks = 0; ks < 4; ++ks) hfr[ks] = *(const LAS bf16x8*)(lds + S_HB + (16 * pt + fr) * 272 + (32 * ks + 8 * fq) * 2);
#pragma unroll
                        for (int ks = 0; ks < 4; ++ks) oa = MFMA16(hfr[ks], cfr[ks], oa);
                        f32x4 yv = yacc[pt] + oa * ec;
                        if (dir == 0) { const u32x2 xv = *(const LAS u32x2*)(lds + S_XS + il * 80 + (16 * pt + 4 * fq) * 2);
                            yv[0] += Dv * bflo(xv.x); yv[1] += Dv * bfhi(xv.x); yv[2] += Dv * bflo(xv.y); yv[3] += Dv * bfhi(xv.y); }
                        else { const u32x2 old = pt == 0 ? ycur0 : ycur1; yv[0] += bflo(old.x); yv[1] += bfhi(old.x); yv[2] += bflo(old.y); yv[3] += bfhi(old.y); }
                        u32x2 o; o.x = cvt_pk_bf16(yv[0], yv[1]); o.y = cvt_pk_bf16(yv[2], yv[3]); ypend[pt] = o;
                    }
                    ypp = Y + (size_t)(currow0 + il) * DIN + xch + 4 * fq;
                }
                { const float dec = AR[1024]; H[0] = H[0] * dec; H[1] = H[1] * dec; }
                {
                    bf16x8 bq[4], xq[2][4];
#pragma unroll
                    for (int ks = 0; ks < 4; ++ks) {
                        const s16x4 blo = tr4(lds + S_BM + (32 * ks + 8 * fq + qq) * 272 + w * 32 + pp * 8), bhi = tr4(lds + S_BM + (32 * ks + 8 * fq + 4 + qq) * 272 + w * 32 + pp * 8);
                        bq[ks] = __builtin_shufflevector(blo, bhi, 0, 1, 2, 3, 4, 5, 6, 7);
#pragma unroll
                        for (int pt = 0; pt < 2; ++pt) {
                            const s16x4 lo = tr4(lds + S_XW + (32 * ks + 8 * fq + qq) * 80 + pt * 32 + pp * 8), hi = tr4(lds + S_XW + (32 * ks + 8 * fq + 4 + qq) * 80 + pt * 32 + pp * 8);
                            xq[pt][ks] = __builtin_shufflevector(lo, hi, 0, 1, 2, 3, 4, 5, 6, 7);
                        }
                    }
#pragma unroll
                    for (int ks = 0; ks < 4; ++ks)
#pragma unroll
                        for (int pt = 0; pt < 2; ++pt) H[pt] = MFMA16(xq[pt][ks], bq[ks], H[pt]);
                }
                if (st + 1 < 34 && w < 2) ssd_scan((LAS float*)(lds + S_AR + ((st + 1) & 1) * AR_BYTES), w, lane, dir, dn0, dn1, Aw);
            }
            if (ypp) { *(u32x2*)ypp = ypend[0]; *(u32x2*)(ypp + 16) = ypend[1]; }
        }
        __syncthreads();
    }
}

#define XB_TMO      128
#define XB_XCNT(j)  (256  + 64 * (j))
#define XB_XSUB(j)  (1280 + 64 * (j))
#define XB_XGEN(j)  (2304 + 64 * (j))
#define XB_TOP      3328
#define XB_TOPGEN   3392
#define XCD_BAR_WORDS 3456
#define XB_SPIN_CAP (1u << 18)

__device__ __forceinline__ unsigned xb_ld(unsigned* p)              { return __hip_atomic_load(p, __ATOMIC_RELAXED, __HIP_MEMORY_SCOPE_AGENT); }
__device__ __forceinline__ unsigned xb_add(unsigned* p, unsigned v) { return __hip_atomic_fetch_add(p, v, __ATOMIC_RELAXED, __HIP_MEMORY_SCOPE_AGENT); }
__device__ __forceinline__ unsigned xb_xcc_id() { return (unsigned)__builtin_amdgcn_s_getreg((3 << 11) | 20) & 0xFu; }
#define XB_SPIN(cond, bar) do { unsigned _sp = 0; while (cond) { __builtin_amdgcn_s_sleep(1); \
    if ((++_sp & 255u) == 0u) { if (xb_ld(&(bar)[XB_TMO])) break; if (_sp > XB_SPIN_CAP) { atomicAdd(&(bar)[XB_TMO], 1u); break; } } } } while (0)

struct XcdBarrier {
    unsigned* bar; unsigned x;
    volatile LAS unsigned* st;
};

__device__ __forceinline__ XcdBarrier xcd_barrier_post(unsigned* bar, volatile LAS unsigned* st) {
    XcdBarrier b; b.bar = bar; b.x = xb_xcc_id(); b.st = st;
    if (threadIdx.x == 0) (void)xb_add(&bar[XB_XCNT(b.x)], 1u);
    return b;
}
__device__ __forceinline__ void xcd_barrier_complete(unsigned* bar, unsigned x, unsigned& nloc, unsigned& nx) {
    const unsigned G = gridDim.x * gridDim.y * gridDim.z;
    unsigned sum, cnt, mine, sp = 0u;
    for (;;) {
        sum = 0u; cnt = 0u; mine = 0u;
#pragma unroll
        for (unsigned j = 0; j < 16; ++j) { const unsigned c = xb_ld(&bar[XB_XCNT(j)]); sum += c; cnt += (c > 0u) ? 1u : 0u; mine = (j == x) ? c : mine; }
        if (sum == G) break;
        __builtin_amdgcn_s_sleep(1);
        if ((++sp & 255u) == 0u) { if (xb_ld(&bar[XB_TMO])) break; if (sp > XB_SPIN_CAP) { atomicAdd(&bar[XB_TMO], 1u); break; } }
    }
    nloc = mine > 0u ? mine : 1u; nx = cnt > 0u ? cnt : 1u;
}

__device__ __forceinline__ void xcd_barrier(const XcdBarrier& b) {
    asm volatile("s_waitcnt vmcnt(0)" ::: "memory");
    __syncthreads();
    if (threadIdx.x == 0) {
        unsigned* bar = b.bar;
        __builtin_amdgcn_s_waitcnt(0);
        unsigned nloc = b.st[0], nx = b.st[1];
        if (nloc == 0u) { xcd_barrier_complete(bar, b.x, nloc, nx); b.st[0] = nloc; b.st[1] = nx; }
        const unsigned old = xb_add(&bar[XB_XSUB(b.x)], 1u);
        const unsigned gen = old / nloc;
        if (old + 1u == (gen + 1u) * nloc) {
            __builtin_amdgcn_fence(__ATOMIC_RELEASE, "agent");
            asm volatile("s_waitcnt vmcnt(0)" ::: "memory");
            const unsigned og = xb_add(&bar[XB_TOP], 1u);
            const unsigned tg = og / nx;
            if (og + 1u == (tg + 1u) * nx) xb_add(&bar[XB_TOPGEN], 1u);
            else XB_SPIN(xb_ld(&bar[XB_TOPGEN]) == tg, bar);
            __builtin_amdgcn_fence(__ATOMIC_ACQUIRE, "agent");
            xb_add(&bar[XB_XGEN(b.x)], 1u);
            asm volatile("s_waitcnt vmcnt(0)" ::: "memory");
        } else {
            XB_SPIN(xb_ld(&bar[XB_XGEN(b.x)]) == gen, bar);
            __builtin_amdgcn_fence(__ATOMIC_ACQUIRE, "agent");
            asm volatile("s_waitcnt vmcnt(0)" ::: "memory");
        }
    }
    __syncthreads();
}

constexpr int NPHASE = 18;
#define REP_ATT 1
#define REP_SSD 1
#define REP_GEMM 1
#define REP_NORM 1
#define XSYNC 0
#ifndef PHMASK
#define PHMASK 0x3ffff
#endif
#define PHON(k) ((PHMASK >> (k)) & 1)
template <bool COOP>
__global__ void __launch_bounds__(512) mega(Params P) {
    extern __shared__ __attribute__((aligned(16))) unsigned char lds_raw[];
    LAS unsigned char* lds = (LAS unsigned char*)lds_raw;
    const int tid = threadIdx.x, lane = tid & 63, wave = __builtin_amdgcn_readfirstlane(tid >> 6);
    const int G = gridDim.x; const int bx = blockIdx.x; const int vcu = (G % 8 == 0) ? (bx % 8) * (G / 8) + bx / 8 : bx;
    const int gw = vcu * 8 + wave, NGW = G * 8;
    unsigned char* ws = P.ws;
#define MOD ((float*)(P.ws + WS_MOD))
#define rope ((const float*)(P.ws + WS_ROPE))
#define CTXR ((float*)(P.ws + WS_CTXR))
#define HN ((bf16_t*)(P.ws + WS_HN))
#define DTb ((float*)(P.ws + WS_DT))
#define x_in (P.in[0])
#define ctx_in (P.in[2])
#define xo (P.out)
    const int lo = P.ph_lo, hi = P.ph_hi;
    volatile LAS unsigned* xst = (volatile LAS unsigned*)(lds + 159984);
    if (tid < 2) xst[tid] = 0u;
    __syncthreads();
    XcdBarrier xb = xcd_barrier_post((unsigned*)(ws + WS_BAR), xst);
    if (hi > 1000) cg::this_grid().sync();
#define IN(k) (PHON(k) && lo <= (k) && (k) < hi)
#define SYNC(k) do { if ((k) + 1 < hi) { xcd_barrier(xb); } } while (0)
#define NORM_PH(k, layer, second, xL, xC, nrows, NS_, goff_) if (IN(k)) { \
        const CtxPart cp{(const float*)(ws + WS_PARTA), (const float*)(ws + WS_PARTB), MOD + 4 * 6144 + (goff_), CTXR, NS_}; \
        for (int rep = 0; rep < REP_NORM; ++rep) norm_phase(xL, xC, ((second) ? P.in[7] : P.in[6]) + (layer) * 1024, MOD + (layer) * 5 * 6144, (second) ? 3072 : 0, (second) ? 4096 : 1024, HN, nrows, gw, NGW, lane, cp); SYNC(k); }
#define RES_PH(k, Aoff, Boff, M_, K_, bL, bC, goff) if (IN(k)) { \
        pg8::Gemm gm{(const bf16_t*)(ws + (Aoff)), (const bf16_t*)(ws + (Boff)), M_, 1024, K_, K_}; pg8::StaticOrder S; S.init(M_, 1024, G, bx); \
        EpiRes E{bL, bC, xo, CTXR, MOD + (goff)}; pg8::gemm_phase<EpiRes, pg8::StaticOrder, true, true>(lds, gm, S, E); if ((k) != 4 && (k) != 7) SYNC(k); }
#define RESCTX_PH(k, Aoff, Boff, K_, NS) if (IN(k)) { \
        pg8::Gemm gm{(const bf16_t*)(ws + (Aoff)), (const bf16_t*)(ws + (Boff)), MT, 1024, (K_) / (NS), K_}; pg8::SplitOrder S{64, 4, 4, NS, G, bx}; \
        EpiPart E{(float*)(ws + WS_PARTA), (float*)(ws + WS_PARTB)}; pg8::gemm_phase<EpiPart, pg8::SplitOrder, true, true>(lds, gm, S, E); SYNC(k); }
#define SWI_PH(k, Boff, Hoff, M_) if (IN(k)) { \
        pg8::Gemm gm{HN, (const bf16_t*)(ws + (Boff)), M_, 2 * DFF, 1024, 1024}; pg8::StaticOrder S; S.init(M_, 2 * DFF, G, bx); \
        EpiSwi E{(bf16_t*)(ws + (Hoff))}; for (int rep = 0; rep < REP_GEMM; ++rep) pg8::gemm_phase<EpiSwi, pg8::StaticOrder, true, true>(lds, gm, S, E); SYNC(k); }

    if (IN(0)) { phase0(P, lds, vcu, G); SYNC(0); for (int rep = 0; rep < XSYNC; ++rep) xcd_barrier(xb); }
    NORM_PH(1, 0, false, x_in, ctx_in, MT, 0, 0)
    if (IN(2)) {
        pg8::Gemm gm{HN, (const bf16_t*)(ws + WS_WQKV), MT, 1536, 1024, 1024}; pg8::StaticOrder S; S.init(MT, 1536, G, bx);
        EpiQKV E{(bf16_t*)(ws + WS_Q), (bf16_t*)(ws + WS_K), (bf16_t*)(ws + WS_VT), rope};
        for (int rep = 0; rep < REP_GEMM; ++rep) pg8::gemm_phase<EpiQKV, pg8::StaticOrder, true, true>(lds, gm, S, E); SYNC(2);
    }
    if (IN(3)) { for (int rep = 0; rep < REP_ATT; ++rep) attn_phase(lds, (const bf16_t*)(ws + WS_Q), HN, (const bf16_t*)(ws + WS_K), (const bf16_t*)(ws + WS_VT), P.in[10], vcu, G); SYNC(3); }
    RES_PH(4, WS_HN, WS_WO, ML, 1024, x_in, ctx_in, 2048)
    RESCTX_PH(4, WS_HN, WS_WO, 1024, 4)
    NORM_PH(5, 0, true, xo, ctx_in, MT, 4, 2048)
    SWI_PH(6, WS_GU0, WS_HB0, MT)
    RES_PH(7, WS_HB0, WS_DN0, ML, DFF, xo, CTXR, 5120)
    RESCTX_PH(7, WS_HB0, WS_DN0, DFF, 11)
    NORM_PH(8, 1, false, xo, CTXR, MT, 11, 5120)
    if (IN(9)) {
        pg8::Gemm gm{HN, (const bf16_t*)(ws + WS_WXBC), MT, NXBCP, 1024, 1024}; pg8::StaticOrder S; S.init(MT, NXBCP, G, bx);
        EpiXbc E{(bf16_t*)(ws + WS_XBC), DTb, P.in[14]};
        for (int rep = 0; rep < REP_GEMM; ++rep) pg8::gemm_phase<EpiXbc, pg8::StaticOrder, true, true>(lds, gm, S, E); SYNC(9);
    }
    if (IN(10)) {
        { ConvHalo hh; conv_capture(hh, (const bf16_t*)(ws + WS_XBC), gw, NGW, lane);
          xcd_barrier(xb);
          conv_apply(hh, (bf16_t*)(ws + WS_XBC), P.in[12], P.in[13], gw, NGW, lane);
          xcd_barrier(xb); }
        for (int rep = 0; rep < REP_SSD; ++rep) ssd_phase(lds, (const bf16_t*)(ws + WS_XBC), DTb, (bf16_t*)(ws + WS_Y), P.in[12], P.in[13], P.in[15], P.in[16], vcu, G); SYNC(10); }
    if (IN(11)) {
        pg8::Gemm gm{HN, (const bf16_t*)(ws + WS_WZ), ML, DIN, 1024, 1024}; pg8::StaticOrder S; S.init(ML, DIN, G, bx);
        EpiZ E{(bf16_t*)(ws + WS_Y), P.in[17], (LAS float*)(lds + 132096)};
        pg8::gemm_phase<EpiZ, pg8::StaticOrder, true, true>(lds, gm, S, E); SYNC(11);
    }
    RES_PH(13, WS_Y, WS_WOUT, ML, DIN, xo, CTXR, 5 * 6144 + 2048)
    if (IN(14)) phase_conv_ffn1(P, lds, vcu, G);
    NORM_PH(14, 1, true, xo, CTXR, ML, 0, 0)
    SWI_PH(15, WS_GU1, WS_HB1, ML)
    RES_PH(16, WS_HB1, WS_DN1, ML, DFF, xo, CTXR, 5 * 6144 + 5120)
    if (IN(17)) { final_norm_phase(xo, P.in[22], gw, NGW, lane); }
}

extern "C" void kernel_launch(void* const* d_in, const int* in_sizes, int n_in, void* d_out, int out_size, void* d_ws, size_t ws_size, hipStream_t stream) {
    static int grid = 0;
    if (grid == 0) {
        if (n_in != 23 || out_size != ML * DM || ws_size < WS_END) { fprintf(stderr, "kernel_launch: unexpected shapes (n_in %d out %d ws %zu)\n", n_in, out_size, ws_size); grid = -1; return; }
        int dev = 0, cus = 0, per_cu = 0;
        (void)hipGetDevice(&dev); (void)hipDeviceGetAttribute(&cus, hipDeviceAttributeMultiprocessorCount, dev);
        (void)hipFuncSetAttribute((const void*)mega<true>, hipFuncAttributeMaxDynamicSharedMemorySize, LDS_BYTES);
        (void)hipOccupancyMaxActiveBlocksPerMultiprocessor(&per_cu, (const void*)mega<true>, 512, LDS_BYTES);
        if (per_cu < 1) fprintf(stderr, "kernel_launch: occupancy query says %d blocks/CU\n", per_cu);
        (void)hipGetLastError();
        grid = cus >= 256 ? 256 : cus;
        if (grid <= 0) grid = 256;
    }
    if (grid < 0) return;
    (void)hipMemsetAsync((char*)d_ws, 0, CTL_BYTES, stream);
    Params p{};
    for (int i = 0; i < 23; ++i) p.in[i] = (const float*)d_in[i];
    p.out = (float*)d_out; p.ws = (unsigned char*)d_ws;
    p.ph_lo = 0; p.ph_hi = NPHASE;
    void* args[] = {&p};
    hipError_t e = hipLaunchCooperativeKernel((const void*)mega<true>, dim3(grid), dim3(512), args, LDS_BYTES, stream);
    if (e != hipSuccess) fprintf(stderr, "cooperative launch failed: %s (grid %d)\n", hipGetErrorString(e), grid);
}
```

```cpp
#include <hip/hip_runtime.h>
#include <hip/hip_cooperative_groups.h>
#include <cstdio>
#include <cstdint>
namespace cg = cooperative_groups;
namespace pg8 {
#define PG8_LAS __attribute__((address_space(3)))
typedef unsigned short bf16_t;
typedef short bf16x8 __attribute__((ext_vector_type(8)));
typedef float f32x4 __attribute__((ext_vector_type(4)));
typedef unsigned u32x4 __attribute__((ext_vector_type(4)));
constexpr int BM = 256, BK = 64, HALF = 128, HTB = HALF * BK * 2  , STAGE_BYTES = 8 * HTB, NXCD = 8, WGM = 8;

__host__ __device__ __forceinline__ int lds_byte(int r, int c) { const int st = (r >> 4) * 2 + (c >> 5), rr = r & 15, cc = c & 31, ob = rr * 64 + cc * 2; return st * 1024 + (ob ^ (((ob >> 9) & 1) << 5)); }
__host__ __device__ __forceinline__ void stage_rc(int b, int& R, int& C) { const int st = b / 1024, sb = b % 1024, swz = sb ^ (((sb >> 9) & 1) << 5); R = (st >> 1) * 16 + swz / 64; C = (st & 1) * 32 + (swz % 64) / 2; }
__host__ __device__ __forceinline__ int perm32(int rho) { const int n = rho >> 4, i = rho & 15; return 8 * (i >> 2) + 4 * n + (i & 3); }

struct Unit { int pm, pn, pk; };
struct Gemm { const bf16_t* A; const bf16_t* Bt; int M, N, K, ld; };

struct StaticOrder {
    int nM, nN, nwg, G, c;
    __host__ __device__ void init(int M, int N, int G_, int c_) { nM = M / BM; nN = N / BM; nwg = nM * nN; G = G_; c = c_; }
    __host__ __device__ bool next(int i, Unit& u) const {
        const long L = (long)i * G + c; if (L >= nwg) return false;
        int wgid = (int)L; { const int q = nwg / NXCD, r = nwg % NXCD, xcd = wgid % NXCD, off = wgid / NXCD; wgid = (xcd < r ? xcd * (q + 1) : r * (q + 1) + (xcd - r) * q) + off; }
        const int nig = WGM * nN, gid = wgid / nig, fm = gid * WGM, gsz = (nM - fm) < WGM ? (nM - fm) : WGM;
        u.pm = fm + ((wgid % nig) % gsz); u.pn = (wgid % nig) / gsz; u.pk = 0; return true;
    }
    __device__ __forceinline__ void a_ready(const Unit&) const {}
    __device__ __forceinline__ void done(const Unit&) const {}
};
struct SplitOrder {
    int pm0, npm, nN, ns, G, c;
    __host__ __device__ bool next(int i, Unit& u) const { const int L = i * G + c; if (L >= npm * nN * ns) return false; u.pk = L % ns; const int r = L / ns; u.pn = r % nN; u.pm = pm0 + r / nN; return true; }
    __device__ __forceinline__ void a_ready(const Unit&) const {}
    __device__ __forceinline__ void done(const Unit&) const {}
};
__device__ __forceinline__ unsigned cvt_pk_bf16(float lo, float hi) { unsigned r; asm volatile("v_cvt_pk_bf16_f32 %0, %1, %2" : "=v"(r) : "v"(lo), "v"(hi)); return r; }
template <class Epi, class Sched, bool ALIGN_EPI = false, bool SP2 = false>
__device__ __forceinline__ void gemm_phase(PG8_LAS unsigned char* lds, const Gemm g, const Sched& S, const Epi& E) {
    const int tid = threadIdx.x, wid = __builtin_amdgcn_readfirstlane(tid >> 6), lane = tid & 63, wr = wid >> 2, wc = wid & 3, fr = lane & 15, fq = lane >> 4;
    const int K = g.K, nt = K / BK, LD = g.ld;
    unsigned voffA[2], voffB[2];
#pragma unroll
    for (int i = 0; i < 2; ++i) { int R, C; stage_rc(tid * 16 + i * 8192, R, C); const int Rb = Epi::PERM ? ((R & ~31) + perm32(R & 31)) : R;
        voffA[i] = (unsigned)(R * LD + C) * 2u; voffB[i] = (unsigned)(Rb * LD + C) * 2u; }
    const size_t kstep = (size_t)(BK * 2);
    const size_t hstep = (size_t)HALF * LD * 2;
    const size_t tstep = 2 * hstep;
    const unsigned ldsw = (unsigned)wid * 1024u;
    const int aoff = lds_byte(wr * 64 + fr, fq * 8), boff = lds_byte(wc * 32 + fr, fq * 8);
#define PG8_SA(b, h) (((b) * 2 + (h)) * HTB)
#define PG8_SB(b, h) ((4 + (b) * 2 + (h)) * HTB)
#define PG8_STAGE(bufoff, gbase, voff) do { _Pragma("unroll") for (int _i = 0; _i < 2; ++_i) \
        __builtin_amdgcn_global_load_lds((const unsigned*)((const char*)(gbase) + (voff)[_i]), (PG8_LAS unsigned*)(lds + (bufoff) + ldsw + _i * 8192), 16, 0, 0); } while (0)
#define PG8_LDA(dst, b, h) do { _Pragma("unroll") for (int m = 0; m < 4; ++m) _Pragma("unroll") for (int k = 0; k < 2; ++k) dst[m][k] = *(const PG8_LAS bf16x8*)(lds + PG8_SA(b, h) + aoff + m * 2048 + k * 1024); } while (0)
#define PG8_LDB(dst, b, h) do { _Pragma("unroll") for (int n = 0; n < 2; ++n) _Pragma("unroll") for (int k = 0; k < 2; ++k) dst[n][k] = *(const PG8_LAS bf16x8*)(lds + PG8_SB(b, h) + boff + n * 2048 + k * 1024); } while (0)
#define PG8_MMA(ai, bj, At, Bt) do { __builtin_amdgcn_s_setprio(1); _Pragma("unroll") for (int m = 0; m < 4; ++m) _Pragma("unroll") for (int n = 0; n < 2; ++n) _Pragma("unroll") for (int k = 0; k < 2; ++k) \
        acc[ai][bj][m][n] = __builtin_amdgcn_mfma_f32_16x16x32_bf16(Bt[n][k], At[m][k], acc[ai][bj][m][n], 0, 0, 0); __builtin_amdgcn_s_setprio(0); } while (0)
#define PG8_WAIT_V(n) asm volatile("s_waitcnt vmcnt(" #n ")" ::: "memory")
#define PG8_WAIT_L(n) asm volatile("s_waitcnt lgkmcnt(" #n ")" ::: "memory")
#define PG8_BAR __builtin_amdgcn_s_barrier()
#define PG8_SCHED __builtin_amdgcn_sched_barrier(0)
    Unit cur, nxt; int ui = 0;
    if (!S.next(0, cur)) return;
    f32x4 acc[2][2][4][2];
#pragma unroll
    for (int a = 0; a < 2; ++a)
#pragma unroll
        for (int b = 0; b < 2; ++b)
#pragma unroll
            for (int m = 0; m < 4; ++m)
#pragma unroll
                for (int n = 0; n < 2; ++n) acc[a][b][m][n] = (f32x4){0.f, 0.f, 0.f, 0.f};
    bf16x8 At[4][2], B0[2][2], B1[2][2];
    const char* cA = (const char*)g.A + (size_t)cur.pm * tstep + (size_t)cur.pk * K * 2; const char* cB = (const char*)g.Bt + (size_t)cur.pn * tstep + (size_t)cur.pk * K * 2;
    S.a_ready(cur);
    if constexpr (SP2) {
        PG8_STAGE(PG8_SB(0, 0), cB, voffB); PG8_STAGE(PG8_SB(0, 1), cB + hstep, voffB); PG8_STAGE(PG8_SA(0, 0), cA, voffA); PG8_STAGE(PG8_SA(0, 1), cA + hstep, voffA);
        if (wr == 1) PG8_BAR;
        PG8_WAIT_V(2); PG8_BAR;
        PG8_STAGE(PG8_SB(1, 0), cB + kstep, voffB); PG8_STAGE(PG8_SA(1, 0), cA + kstep, voffA); PG8_STAGE(PG8_SB(1, 1), cB + hstep + kstep, voffB);
        PG8_WAIT_V(6); PG8_BAR;
    } else {
        PG8_STAGE(PG8_SB(0, 0), cB, voffB); PG8_STAGE(PG8_SA(0, 0), cA, voffA); PG8_STAGE(PG8_SB(0, 1), cB + hstep, voffB); PG8_STAGE(PG8_SA(0, 1), cA + hstep, voffA);
        if (wr == 1) PG8_BAR;
        PG8_WAIT_V(4); PG8_BAR;
        PG8_STAGE(PG8_SB(1, 0), cB + kstep, voffB); PG8_STAGE(PG8_SA(1, 0), cA + kstep, voffA); PG8_STAGE(PG8_SB(1, 1), cB + hstep + kstep, voffB);
        PG8_WAIT_V(6); PG8_BAR;
    }
    for (;;) {
        const bool has_next = S.next(ui + 1, nxt);
        const char* nA = has_next ? (const char*)g.A + (size_t)nxt.pm * tstep + (size_t)nxt.pk * K * 2 : cA; const char* nB = has_next ? (const char*)g.Bt + (size_t)nxt.pn * tstep + (size_t)nxt.pk * K * 2 : cB;
        for (int t = 0; t < nt; t += 2) {
            const bool last = (t == nt - 2);
            const char* a1 = cA + (size_t)(t + 1) * kstep;
            const char* a2 = last ? nA : cA + (size_t)(t + 2) * kstep; const char* b2 = last ? nB : cB + (size_t)(t + 2) * kstep;
            const char* a3 = a2 + kstep; const char* b3 = b2 + kstep;
            if (last && has_next) S.a_ready(nxt);
            if constexpr (SP2) {
            PG8_LDB(B0, 0, 0); PG8_LDB(B1, 0, 1); PG8_SCHED; PG8_LDA(At, 0, 0); PG8_STAGE(PG8_SA(1, 1), a1 + hstep, voffA);
            PG8_WAIT_V(8); PG8_WAIT_L(0); PG8_BAR; PG8_MMA(0, 0, At, B0); PG8_MMA(0, 1, At, B1); PG8_BAR; PG8_SCHED;
            PG8_LDA(At, 0, 1); PG8_STAGE(PG8_SB(0, 0), b2, voffB); PG8_STAGE(PG8_SB(0, 1), b2 + hstep, voffB); PG8_STAGE(PG8_SA(0, 0), a2, voffA);
            PG8_WAIT_V(8); PG8_WAIT_L(0); PG8_BAR; PG8_MMA(1, 0, At, B0); PG8_MMA(1, 1, At, B1); PG8_BAR; PG8_SCHED;
            PG8_LDB(B0, 1, 0); PG8_LDB(B1, 1, 1); PG8_SCHED; PG8_LDA(At, 1, 0); PG8_STAGE(PG8_SA(0, 1), a2 + hstep, voffA);
            PG8_WAIT_V(8); PG8_WAIT_L(0); PG8_BAR; PG8_MMA(0, 0, At, B0); PG8_MMA(0, 1, At, B1); PG8_BAR; PG8_SCHED;
            PG8_LDA(At, 1, 1); PG8_STAGE(PG8_SB(1, 0), b3, voffB); PG8_STAGE(PG8_SB(1, 1), b3 + hstep, voffB); PG8_STAGE(PG8_SA(1, 0), a3, voffA);
            PG8_WAIT_V(8); PG8_WAIT_L(0); PG8_BAR; PG8_MMA(1, 0, At, B0); PG8_MMA(1, 1, At, B1); PG8_BAR; PG8_SCHED;
            } else {
            PG8_LDB(B0, 0, 0); PG8_SCHED; PG8_LDA(At, 0, 0); PG8_STAGE(PG8_SA(1, 1), a1 + hstep, voffA);
            PG8_WAIT_L(8); PG8_BAR; PG8_WAIT_L(0); PG8_MMA(0, 0, At, B0); PG8_BAR; PG8_SCHED;
            PG8_LDB(B1, 0, 1); PG8_STAGE(PG8_SB(0, 0), b2, voffB);
            PG8_BAR; PG8_WAIT_L(0); PG8_MMA(0, 1, At, B1); PG8_BAR;
            PG8_LDA(At, 0, 1); PG8_STAGE(PG8_SA(0, 0), a2, voffA);
            PG8_BAR; PG8_WAIT_L(0); PG8_MMA(1, 0, At, B0); PG8_BAR; PG8_SCHED;
            PG8_STAGE(PG8_SB(0, 1), b2 + hstep, voffB);
            PG8_WAIT_V(6); PG8_BAR; PG8_MMA(1, 1, At, B1); PG8_BAR;
            PG8_LDB(B0, 1, 0); PG8_SCHED; PG8_LDA(At, 1, 0); PG8_STAGE(PG8_SA(0, 1), a2 + hstep, voffA);
            PG8_WAIT_L(8); PG8_BAR; PG8_WAIT_L(0); PG8_MMA(0, 0, At, B0); PG8_BAR; PG8_SCHED;
            PG8_LDB(B1, 1, 1); PG8_STAGE(PG8_SB(1, 0), b3, voffB);
            PG8_BAR; PG8_WAIT_L(0); PG8_MMA(0, 1, At, B1); PG8_BAR;
            PG8_LDA(At, 1, 1); PG8_STAGE(PG8_SA(1, 0), a3, voffA);
            PG8_BAR; PG8_WAIT_L(0); PG8_MMA(1, 0, At, B0); PG8_BAR; PG8_SCHED;
            PG8_STAGE(PG8_SB(1, 1), b3 + hstep, voffB);
            PG8_WAIT_V(6); PG8_BAR; PG8_MMA(1, 1, At, B1); PG8_BAR;
            }
        }
        if constexpr (ALIGN_EPI) { if (wr == 0) PG8_BAR; }
        if constexpr (!Epi::AFTER_DRAIN) { E(acc, cur, wr, wc, fr, fq); S.done(cur); }
        if (!has_next) break;
#pragma unroll
        for (int a = 0; a < 2; ++a)
#pragma unroll
            for (int b = 0; b < 2; ++b)
#pragma unroll
                for (int m = 0; m < 4; ++m)
#pragma unroll
                    for (int n = 0; n < 2; ++n) acc[a][b][m][n] = (f32x4){0.f, 0.f, 0.f, 0.f};
        cur = nxt; cA = nA; cB = nB; ++ui;
        if constexpr (ALIGN_EPI) { if (wr == 1) PG8_BAR; }
    }
    PG8_WAIT_V(0);
    if constexpr (!ALIGN_EPI) { if (wr == 0) PG8_BAR; }
    PG8_BAR;
    if constexpr (Epi::AFTER_DRAIN) { E.fused(acc, cur, wr, wc, fr, fq, lds, wid, lane); S.done(cur); }
#undef PG8_SA
#undef PG8_SB
#undef PG8_STAGE
#undef PG8_LDA
#undef PG8_LDB
#undef PG8_MMA
#undef PG8_WAIT_V
#undef PG8_WAIT_L
#undef PG8_BAR
#undef PG8_SCHED
}
}

#define DI __device__ __forceinline__
#define LAS __attribute__((address_space(3)))
typedef unsigned short bf16_t;
typedef short bf16x8 __attribute__((ext_vector_type(8)));
typedef short s16x4 __attribute__((ext_vector_type(4)));
typedef float f32x4 __attribute__((ext_vector_type(4)));
typedef float f32x2 __attribute__((ext_vector_type(2)));
typedef float f32x16 __attribute__((ext_vector_type(16)));
typedef unsigned u32x4 __attribute__((ext_vector_type(4)));
typedef unsigned u32x2 __attribute__((ext_vector_type(2)));
using pg8::cvt_pk_bf16;

constexpr int DM = 1024, NB = 4, SEQ = 4096, CTXL = 256;
constexpr int ML = NB * SEQ;
constexpr int MC = NB * CTXL;
constexpr int MT = ML + MC;
constexpr int DFF = 2816, DIN = 2048, NXBC = 4096, NXBCP = 4352, VTP = 4352;
constexpr float EPS = 1e-6f;
constexpr float LOG2E = 1.4426950408889634f;
constexpr float QSCALE = 0.125f * LOG2E;

constexpr size_t MiB = 1u << 20;
constexpr size_t WS_MOD = 0;
constexpr size_t WS_SSQ = 256 * 1024;
constexpr size_t WS_BAR = 800 * 1024;
constexpr size_t WS_ROPE = 900 * 1024;
constexpr size_t CTL_BYTES = 1 * MiB;
constexpr size_t WS_CTXR = 1 * MiB;
constexpr size_t WS_HN = 5 * MiB;
constexpr size_t WS_DT = 39 * MiB;
constexpr size_t WS_WZ = 44 * MiB;
constexpr size_t WS_WOUT = 48 * MiB;
constexpr size_t WS_Q = 56 * MiB;
constexpr size_t WS_K = 90 * MiB;
constexpr size_t WS_VT = 99 * MiB;
constexpr size_t WS_HB0 = 56 * MiB;
constexpr size_t WS_XBC = 56 * MiB;
constexpr size_t WS_GU1 = 56 * MiB;
constexpr size_t WS_DN1 = 67 * MiB;
constexpr size_t WS_HB1 = 73 * MiB;
constexpr size_t WS_WXBC = 192 * MiB;
constexpr size_t WS_WQKV = 201 * MiB;
constexpr size_t WS_WO = 204 * MiB;
constexpr size_t WS_GU0 = 206 * MiB;
constexpr size_t WS_DN0 = 217 * MiB;
constexpr size_t WS_Y = 192 * MiB;
constexpr size_t WS_PARTA = 150 * MiB;
constexpr size_t WS_PARTB = 223 * MiB;
constexpr size_t WS_END = 256 * MiB;

constexpr int LDS_BYTES = 160000;

DI float bflo(unsigned u) { return __uint_as_float(u << 16); }
DI float bfhi(unsigned u) { return __uint_as_float(u & 0xffff0000u); }
DI float silu_f(float x) { return x * __builtin_amdgcn_rcpf(1.0f + __expf(-x)); }
DI float wave_sum(float v) {
#pragma unroll
    for (int o = 1; o < 64; o <<= 1) v += __shfl_xor(v, o);
    return v;
}
#define LDS_WAIT() asm volatile("s_waitcnt lgkmcnt(0)" ::: "memory")

struct EpiQKV {
    static constexpr bool PERM = false, AFTER_DRAIN = false;
    bf16_t* Q; bf16_t* K; bf16_t* VT; const float* rope;
    DI void operator()(const f32x4 (&acc)[2][2][4][2], const pg8::Unit& u, int wr, int wc, int fr, int fq) const {
        const int pn = u.pn; const bool isctx = u.pm >= 64;
#pragma unroll
        for (int ai = 0; ai < 2; ++ai)
#pragma unroll
            for (int m = 0; m < 4; ++m) {
                const int row = u.pm * 256 + ai * 128 + wr * 64 + m * 16 + fr;
                int b, t; if (!isctx) { b = row >> 12; t = row & 4095; } else { const int rc = row - ML; b = rc >> 8; t = rc & 255; }
#pragma unroll
                for (int bj = 0; bj < 2; ++bj) {
                    f32x4 v0 = acc[ai][bj][m][0], v1 = acc[ai][bj][m][1];
                    const int colt = bj * 128 + wc * 32;
                    if (pn < 5 && !isctx) {
                        const int pos = (wc & 1) ? (t & 63) : (t >> 6);
                        const f32x4 c4 = *(const f32x4*)(rope + pos * 16 + 4 * fq), s4 = *(const f32x4*)(rope + 1024 + pos * 16 + 4 * fq);
                        const f32x4 r0 = v0 * c4 - v1 * s4, r1 = v1 * c4 + v0 * s4; v0 = r0; v1 = r1;
                    }
                    if (pn < 4) {
                        v0 = v0 * QSCALE; v1 = v1 * QSCALE;
                        bf16_t* p = Q + (size_t)row * 1024 + pn * 256 + colt + 4 * fq;
                        u32x2 a; a.x = cvt_pk_bf16(v0[0], v0[1]); a.y = cvt_pk_bf16(v0[2], v0[3]); *(u32x2*)p = a;
                        u32x2 c; c.x = cvt_pk_bf16(v1[0], v1[1]); c.y = cvt_pk_bf16(v1[2], v1[3]); *(u32x2*)(p + 16) = c;
                    } else if (pn == 4) {
                        bf16_t* p = K + (size_t)row * 256 + colt + 4 * fq;
                        u32x2 a; a.x = cvt_pk_bf16(v0[0], v0[1]); a.y = cvt_pk_bf16(v0[2], v0[3]); *(u32x2*)p = a;
                        u32x2 c; c.x = cvt_pk_bf16(v1[0], v1[1]); c.y = cvt_pk_bf16(v1[2], v1[3]); *(u32x2*)(p + 16) = c;
                    } else {
                        const int g = bj * 2 + (wc >> 1); const int d0 = (wc & 1) * 32 + 4 * fq; const int pos = isctx ? 4096 + t : t;
                        bf16_t* p = VT + ((size_t)((b * 4 + g) * 64 + d0)) * VTP + pos;
#pragma unroll
                        for (int e = 0; e < 4; ++e) {
                            p[(size_t)e * VTP] = (bf16_t)(cvt_pk_bf16(v0[e], 0.f) & 0xffffu);
                            p[(size_t)(16 + e) * VTP] = (bf16_t)(cvt_pk_bf16(v1[e], 0.f) & 0xffffu);
                        }
                    }
                }
            }
    }
};

struct EpiRes {
    static constexpr bool PERM = false, AFTER_DRAIN = false;
    const float* baseL; const float* baseC; float* outL; float* outC; const float* gate;
    DI void operator()(const f32x4 (&acc)[2][2][4][2], const pg8::Unit& u, int wr, int wc, int fr, int fq) const {
        const bool isctx = u.pm >= 64; const int mrow = isctx ? 4 : (u.pm >> 4);
        const float* base = isctx ? baseC - (size_t)ML * 1024 : baseL; float* out = isctx ? outC - (size_t)ML * 1024 : outL;
#pragma unroll
        for (int bj = 0; bj < 2; ++bj)
#pragma unroll
            for (int n = 0; n < 2; ++n) {
                const int col = u.pn * 256 + bj * 128 + wc * 32 + 16 * n + 4 * fq;
                const f32x4 g4 = *(const f32x4*)(gate + mrow * 6144 + col);
#pragma unroll
                for (int ai = 0; ai < 2; ++ai)
#pragma unroll
                    for (int m = 0; m < 4; ++m) {
                        const size_t off = (size_t)(u.pm * 256 + ai * 128 + wr * 64 + m * 16 + fr) * 1024 + col;
                        const f32x4 bs = *(const f32x4*)(base + off);
                        *(f32x4*)(out + off) = bs + g4 * acc[ai][bj][m][n];
                    }
            }
    }
};

struct EpiPart {
    static constexpr bool PERM = false, AFTER_DRAIN = false;
    float* pA; float* pB;
    DI void operator()(const f32x4 (&acc)[2][2][4][2], const pg8::Unit& u, int wr, int wc, int fr, int fq) const {
        float* out = (u.pk < 10 ? pA + (size_t)u.pk * MC * 1024 : pB) - (size_t)ML * 1024;
#pragma unroll
        for (int bj = 0; bj < 2; ++bj)
#pragma unroll
            for (int n = 0; n < 2; ++n) {
                const int col = u.pn * 256 + bj * 128 + wc * 32 + 16 * n + 4 * fq;
#pragma unroll
                for (int ai = 0; ai < 2; ++ai)
#pragma unroll
                    for (int m = 0; m < 4; ++m) *(f32x4*)(out + (size_t)(u.pm * 256 + ai * 128 + wr * 64 + m * 16 + fr) * 1024 + col) = acc[ai][bj][m][n];
            }
    }
};

struct EpiSwi {
    static constexpr bool PERM = true, AFTER_DRAIN = false;
    bf16_t* H;
    DI void operator()(const f32x4 (&acc)[2][2][4][2], const pg8::Unit& u, int wr, int wc, int fr, int fq) const {
        const int col = u.pn * 128 + wc * 32 + 8 * fq;
#pragma unroll
        for (int ai = 0; ai < 2; ++ai)
#pragma unroll
            for (int m = 0; m < 4; ++m) {
                const int row = u.pm * 256 + ai * 128 + wr * 64 + m * 16 + fr;
                const f32x4 g0 = acc[ai][0][m][0], g1 = acc[ai][0][m][1], u0 = acc[ai][1][m][0], u1 = acc[ai][1][m][1];
                u32x4 w;
                w.x = cvt_pk_bf16(silu_f(g0[0]) * u0[0], silu_f(g0[1]) * u0[1]); w.y = cvt_pk_bf16(silu_f(g0[2]) * u0[2], silu_f(g0[3]) * u0[3]);
                w.z = cvt_pk_bf16(silu_f(g1[0]) * u1[0], silu_f(g1[1]) * u1[1]); w.w = cvt_pk_bf16(silu_f(g1[2]) * u1[2], silu_f(g1[3]) * u1[3]);
                *(u32x4*)(H + (size_t)row * DFF + col) = w;
            }
    }
};

struct EpiXbc {
    static constexpr bool PERM = true, AFTER_DRAIN = false;
    bf16_t* X; float* DT; const float* dtb;
    DI void operator()(const f32x4 (&acc)[2][2][4][2], const pg8::Unit& u, int wr, int wc, int fr, int fq) const {
        if (u.pn < 16) {
#pragma unroll
            for (int ai = 0; ai < 2; ++ai)
#pragma unroll
                for (int m = 0; m < 4; ++m) {
                    const int row = u.pm * 256 + ai * 128 + wr * 64 + m * 16 + fr;
#pragma unroll
                    for (int bj = 0; bj < 2; ++bj) {
                        const f32x4 v0 = acc[ai][bj][m][0], v1 = acc[ai][bj][m][1];
                        u32x4 w; w.x = cvt_pk_bf16(v0[0], v0[1]); w.y = cvt_pk_bf16(v0[2], v0[3]); w.z = cvt_pk_bf16(v1[0], v1[1]); w.w = cvt_pk_bf16(v1[2], v1[3]);
                        *(u32x4*)(X + (size_t)row * NXBC + u.pn * 256 + bj * 128 + wc * 32 + 8 * fq) = w;
                    }
                }
        } else if (wc < 2) {
#pragma unroll
            for (int n = 0; n < 2; ++n) {
                const int ct = wc * 32 + 8 * fq + 4 * n;
                const f32x4 b4 = *(const f32x4*)(dtb + ct);
#pragma unroll
                for (int ai = 0; ai < 2; ++ai)
#pragma unroll
                    for (int m = 0; m < 4; ++m) {
                        const int row = u.pm * 256 + ai * 128 + wr * 64 + m * 16 + fr;
                        const f32x4 v = acc[ai][0][m][n] + b4; f32x4 o;
#pragma unroll
                        for (int e = 0; e < 4; ++e) o[e] = v[e] > 20.f ? v[e] : log1pf(__expf(v[e]));
                        *(f32x4*)(DT + (size_t)row * 64 + ct) = o;
                    }
            }
        }
    }
};

struct EpiZ {
    static constexpr bool PERM = true, AFTER_DRAIN = false;
    bf16_t* Y; const float* ng; LAS float* P4;
    DI void operator()(f32x4 (&acc)[2][2][4][2], const pg8::Unit& u, int wr, int wc, int fr, int fq) const {
#pragma unroll
        for (int ai = 0; ai < 2; ++ai)
#pragma unroll
            for (int m = 0; m < 4; ++m) {
                const int rl = ai * 128 + wr * 64 + m * 16 + fr; const int row = u.pm * 256 + rl; float ss = 0.f;
#pragma unroll
                for (int bj = 0; bj < 2; ++bj) {
                    const bf16_t* p = Y + (size_t)row * DIN + u.pn * 256 + bj * 128 + wc * 32 + 8 * fq;
                    const u32x4 yv = *(const u32x4*)p; const f32x4 z0 = acc[ai][bj][m][0], z1 = acc[ai][bj][m][1];
                    f32x4 o0, o1;
                    o0[0] = bflo(yv.x) * silu_f(z0[0]); o0[1] = bfhi(yv.x) * silu_f(z0[1]); o0[2] = bflo(yv.y) * silu_f(z0[2]); o0[3] = bfhi(yv.y) * silu_f(z0[3]);
                    o1[0] = bflo(yv.z) * silu_f(z1[0]); o1[1] = bfhi(yv.z) * silu_f(z1[1]); o1[2] = bflo(yv.w) * silu_f(z1[2]); o1[3] = bfhi(yv.w) * silu_f(z1[3]);
                    ss += (o0[0] * o0[0] + o0[1] * o0[1]) + (o0[2] * o0[2] + o0[3] * o0[3]) + (o1[0] * o1[0] + o1[1] * o1[1]) + (o1[2] * o1[2] + o1[3] * o1[3]);
                    acc[ai][bj][m][0] = o0; acc[ai][bj][m][1] = o1;
                }
                ss += __shfl_xor(ss, 16); ss += __shfl_xor(ss, 32);
                if (fq == 0) P4[rl * 4 + wc] = ss;
            }
        asm volatile("s_waitcnt lgkmcnt(0)" ::: "memory"); __builtin_amdgcn_s_barrier(); asm volatile("" ::: "memory");
        f32x4 g[2][2];
#pragma unroll
        for (int bj = 0; bj < 2; ++bj) { g[bj][0] = *(const f32x4*)(ng + u.pn * 256 + bj * 128 + wc * 32 + 8 * fq); g[bj][1] = *(const f32x4*)(ng + u.pn * 256 + bj * 128 + wc * 32 + 8 * fq + 4); }
#pragma unroll
        for (int ai = 0; ai < 2; ++ai)
#pragma unroll
            for (int m = 0; m < 4; ++m) {
                const int rl = ai * 128 + wr * 64 + m * 16 + fr; const int row = u.pm * 256 + rl;
                const f32x4 ps = *(const LAS f32x4*)(P4 + rl * 4);
                const float rstd = 1.0f / sqrtf(((ps[0] + ps[1]) + (ps[2] + ps[3])) * (1.0f / 256.0f) + EPS);
#pragma unroll
                for (int bj = 0; bj < 2; ++bj) {
                    const f32x4 o0 = acc[ai][bj][m][0] * rstd * g[bj][0], o1 = acc[ai][bj][m][1] * rstd * g[bj][1];
                    u32x4 w; w.x = cvt_pk_bf16(o0[0], o0[1]); w.y = cvt_pk_bf16(o0[2], o0[3]); w.z = cvt_pk_bf16(o1[0], o1[1]); w.w = cvt_pk_bf16(o1[2], o1[3]);
                    *(u32x4*)(Y + (size_t)row * DIN + u.pn * 256 + bj * 128 + wc * 32 + 8 * fq) = w;
                }
            }
        asm volatile("s_waitcnt lgkmcnt(0)" ::: "memory"); __builtin_amdgcn_s_barrier(); asm volatile("" ::: "memory");
    }
};

DI void transpose_item(const float* W, int N, bf16_t* WT, int K, int k0, int n0, int drow0, LAS float* scr, int lane) {
#pragma unroll
    for (int i = 0; i < 32; ++i) { const int kk = 2 * i + (lane >> 5); scr[kk * 33 + (lane & 31)] = W[(size_t)(k0 + kk) * N + n0 + (lane & 31)]; }
    LDS_WAIT(); asm volatile("" ::: "memory");
    const int c = lane & 7;
#pragma unroll
    for (int j = 0; j < 4; ++j) { const int n = (lane >> 3) + 8 * j; const LAS float* s = scr + (8 * c) * 33 + n;
        u32x4 o; o.x = cvt_pk_bf16(s[0 * 33], s[1 * 33]); o.y = cvt_pk_bf16(s[2 * 33], s[3 * 33]); o.z = cvt_pk_bf16(s[4 * 33], s[5 * 33]); o.w = cvt_pk_bf16(s[6 * 33], s[7 * 33]);
        *(u32x4*)(WT + (size_t)(drow0 + n) * K + k0 + 8 * c) = o; }
    LDS_WAIT(); asm volatile("" ::: "memory");
}
DI void conv_job(const float* W, int K, int N, bf16_t* T, bf16_t* T2, int mode, int item, LAS float* scr, int lane) {
    const int nblk = N / 32, kb = item / nblk, nb = item - kb * nblk, k0 = 64 * kb, n0 = 32 * nb;
    int drow0 = n0; bf16_t* dst = T;
    if (mode == 1) drow0 = (n0 >> 7) * 256 + (n0 & 127);
    else if (mode == 2) drow0 = (n0 >> 7) * 256 + 128 + (n0 & 127);
    else if (mode == 3) { if (n0 >= 2048) { dst = T2; drow0 = n0 - 2048; } }
    transpose_item(W, N, dst, K, k0, n0, drow0, scr, lane);
}

struct Params { const float* in[23]; float* out; unsigned char* ws; int ph_lo, ph_hi; };

DI void phase0(const Params& P, LAS unsigned char* lds, int vcu, int G) {
    const int tid = threadIdx.x, lane = tid & 63, wave = __builtin_amdgcn_readfirstlane(tid >> 6);
    unsigned char* ws = P.ws;
    LAS float* S = (LAS float*)(lds + 70000);
    for (int i = tid; i < 5 * 1024; i += 512) { const int m = i >> 10, k = i & 1023; const float v = m < 4 ? P.in[1][m * 1024 + k] : P.in[3][k]; S[i] = silu_f(v); }
    __syncthreads();
    float* MOD = (float*)(ws + WS_MOD);
    LAS float* RED = (LAS float*)(lds + 96000);
    for (int it = blockIdx.x; it < 192; it += G) {
        const int l = it / 96, n = (it - l * 96) * 64 + (tid & 63), ksl = tid >> 6;
        const float* w = P.in[4] + (size_t)l * 1024 * 6144 + (size_t)(ksl * 128) * 6144 + n;
        float a0 = 0.f, a1 = 0.f, a2 = 0.f, a3 = 0.f, a4 = 0.f;
#pragma unroll 16
        for (int k = 0; k < 128; ++k) { const float wv = w[(size_t)k * 6144]; const int kk = ksl * 128 + k;
            a0 += S[kk] * wv; a1 += S[1024 + kk] * wv; a2 += S[2048 + kk] * wv; a3 += S[3072 + kk] * wv; a4 += S[4096 + kk] * wv; }
        __syncthreads();
        RED[(ksl * 5 + 0) * 64 + (tid & 63)] = a0; RED[(ksl * 5 + 1) * 64 + (tid & 63)] = a1; RED[(ksl * 5 + 2) * 64 + (tid & 63)] = a2; RED[(ksl * 5 + 3) * 64 + (tid & 63)] = a3; RED[(ksl * 5 + 4) * 64 + (tid & 63)] = a4;
        __syncthreads();
        if (tid < 320) { const int m = tid >> 6, c = tid & 63; float sum = P.in[5][l * 6144 + (it - l * 96) * 64 + c];
#pragma unroll
            for (int q = 0; q < 8; ++q) sum += RED[(q * 5 + m) * 64 + c];
            MOD[(size_t)l * 5 * 6144 + m * 6144 + (it - l * 96) * 64 + c] = sum; }
    }
    if (blockIdx.x == 0) {
        float* rope = (float*)(ws + WS_ROPE);
        for (int i = tid; i < 1024; i += 512) { const int pos = i >> 4, f = i & 15; const float inv = powf(10000.0f, -(float)f / 16.0f); const float ang = (float)pos * inv;
            rope[i] = cosf(ang); rope[1024 + i] = sinf(ang); }
    }
    { bf16_t* wx = (bf16_t*)(ws + WS_WXBC); const int total = (NXBCP - 4160) * 1024 / 8;
      for (int i = blockIdx.x * 512 + tid; i < total; i += G * 512) *(u32x4*)(wx + (size_t)4160 * 1024 + (size_t)i * 8) = (u32x4){0u, 0u, 0u, 0u}; }
    LAS float* scr = (LAS float*)(lds + wave * 8448);
    const int gw = vcu * 8 + wave, NGW = G * 8;
    constexpr int I_QKV = 16 * 48, I_WO = 16 * 32, I_G = 16 * 88, I_D = 44 * 32, I_IN = 16 * 194, I_OUT = 32 * 32;
    constexpr int NIT = I_QKV + I_WO + 2 * I_G + I_D + I_IN + I_OUT;
    for (int it = gw; it < NIT; it += NGW) {
        int r = it;
        if (r < I_QKV) { conv_job(P.in[8], 1024, 1536, (bf16_t*)(ws + WS_WQKV), nullptr, 0, r, scr, lane); continue; } r -= I_QKV;
        if (r < I_WO) { conv_job(P.in[9], 1024, 1024, (bf16_t*)(ws + WS_WO), nullptr, 0, r, scr, lane); continue; } r -= I_WO;
        if (r < I_G) { conv_job(P.in[19], 1024, DFF, (bf16_t*)(ws + WS_GU0), nullptr, 1, r, scr, lane); continue; } r -= I_G;
        if (r < I_G) { conv_job(P.in[20], 1024, DFF, (bf16_t*)(ws + WS_GU0), nullptr, 2, r, scr, lane); continue; } r -= I_G;
        if (r < I_D) { conv_job(P.in[21], DFF, 1024, (bf16_t*)(ws + WS_DN0), nullptr, 0, r, scr, lane); continue; } r -= I_D;
        if (r < I_IN) { conv_job(P.in[11], 1024, 6208, (bf16_t*)(ws + WS_WZ), (bf16_t*)(ws + WS_WXBC), 3, r, scr, lane); continue; } r -= I_IN;
        conv_job(P.in[18], DIN, 1024, (bf16_t*)(ws + WS_WOUT), nullptr, 0, r, scr, lane);
    }
}

DI void phase_conv_ffn1(const Params& P, LAS unsigned char* lds, int vcu, int G) {
    const int tid = threadIdx.x, lane = tid & 63, wave = __builtin_amdgcn_readfirstlane(tid >> 6);
    unsigned char* ws = P.ws;
    LAS float* scr = (LAS float*)(lds + wave * 8448);
    const int gw = vcu * 8 + wave, NGW = G * 8;
    constexpr int I_G = 16 * 88, I_D = 44 * 32, NIT = 2 * I_G + I_D;
    const size_t o1 = (size_t)1024 * DFF;
    for (int it = gw; it < NIT; it += NGW) {
        int r = it;
        if (r < I_G) { conv_job(P.in[19] + o1, 1024, DFF, (bf16_t*)(ws + WS_GU1), nullptr, 1, r, scr, lane); continue; } r -= I_G;
        if (r < I_G) { conv_job(P.in[20] + o1, 1024, DFF, (bf16_t*)(ws + WS_GU1), nullptr, 2, r, scr, lane); continue; } r -= I_G;
        conv_job(P.in[21] + o1, DFF, 1024, (bf16_t*)(ws + WS_DN1), nullptr, 0, r, scr, lane);
    }
}

struct CtxPart { const float* pA; const float* pB; const float* gate; float* ctx_out; int ns; };
DI void norm_phase(const float* xL, const float* xC, const float* g, const float* mod, int shoff, int scoff, bf16_t* HN, int nrows, int gw, int NGW, int lane, const CtxPart cp) {
    for (int row = gw; row < nrows; row += NGW) {
        const float* src = row < ML ? xL + (size_t)row * 1024 : xC + (size_t)(row - ML) * 1024; const int m = row < ML ? (row >> 12) : 4;
        f32x4 v[4]; float ss = 0.f;
#pragma unroll
        for (int j = 0; j < 4; ++j) v[j] = *(const f32x4*)(src + 4 * lane + 256 * j);
        if (row >= ML && cp.ns > 0) {
            const size_t ro = (size_t)(row - ML) * 1024;
#pragma unroll
            for (int j = 0; j < 4; ++j) { const int col = 4 * lane + 256 * j; f32x4 acc4 = (f32x4){0.f, 0.f, 0.f, 0.f};
                for (int k = 0; k < cp.ns; ++k) { const float* pp = (k < 10 ? cp.pA + (size_t)k * MC * 1024 : cp.pB) + ro + col; acc4 += *(const f32x4*)pp; }
                v[j] += *(const f32x4*)(cp.gate + col) * acc4; *(f32x4*)(cp.ctx_out + ro + col) = v[j]; }
        }
#pragma unroll
        for (int j = 0; j < 4; ++j) ss += (v[j].x * v[j].x + v[j].y * v[j].y) + (v[j].z * v[j].z + v[j].w * v[j].w);
        const float rstd = 1.0f / sqrtf(wave_sum(ss) * (1.0f / 1024.0f) + EPS);
#pragma unroll
        for (int j = 0; j < 4; ++j) { const int col = 4 * lane + 256 * j;
            const f32x4 g4 = *(const f32x4*)(g + col), sc = *(const f32x4*)(mod + m * 6144 + scoff + col), sh = *(const f32x4*)(mod + m * 6144 + shoff + col);
            const f32x4 o = (v[j] * rstd * g4) * (sc + 1.0f) + sh;
            u32x2 w; w.x = cvt_pk_bf16(o[0], o[1]); w.y = cvt_pk_bf16(o[2], o[3]); *(u32x2*)(HN + (size_t)row * 1024 + col) = w; }
    }
}
DI void final_norm_phase(float* x, const float* g, int gw, int NGW, int lane) {
    for (int row0 = gw; row0 < ML; row0 += 2 * NGW) {
        const int row1 = row0 + NGW; const bool has1 = row1 < ML; const int r1 = has1 ? row1 : row0;
        float* s0 = x + (size_t)row0 * 1024; float* s1 = x + (size_t)r1 * 1024; f32x4 v0[4], v1[4]; float ss0 = 0.f, ss1 = 0.f;
#pragma unroll
        for (int j = 0; j < 4; ++j) { v0[j] = *(const f32x4*)(s0 + 4 * lane + 256 * j); v1[j] = *(const f32x4*)(s1 + 4 * lane + 256 * j); }
#pragma unroll
        for (int j = 0; j < 4; ++j) { ss0 += (v0[j].x * v0[j].x + v0[j].y * v0[j].y) + (v0[j].z * v0[j].z + v0[j].w * v0[j].w); ss1 += (v1[j].x * v1[j].x + v1[j].y * v1[j].y) + (v1[j].z * v1[j].z + v1[j].w * v1[j].w); }
#pragma unroll
        for (int o = 1; o < 64; o <<= 1) { ss0 += __shfl_xor(ss0, o); ss1 += __shfl_xor(ss1, o); }
        const float rstd0 = 1.0f / sqrtf(ss0 * (1.0f / 1024.0f) + EPS), rstd1 = 1.0f / sqrtf(ss1 * (1.0f / 1024.0f) + EPS);
#pragma unroll
        for (int j = 0; j < 4; ++j) { const int col = 4 * lane + 256 * j; const f32x4 g4 = *(const f32x4*)(g + col);
            *(f32x4*)(s0 + col) = v0[j] * rstd0 * g4; if (has1) *(f32x4*)(s1 + col) = v1[j] * rstd1 * g4; }
    }
}
DI void gnorm_phase(bf16_t* Y, const float* SSQ, const float* ng, int G) {
    const int total = ML * 256;
    for (int i = blockIdx.x * 512 + threadIdx.x; i < total; i += G * 512) {
        const int row = i >> 8, col = (i & 255) * 8; const float rstd = 1.0f / sqrtf(SSQ[(size_t)row * 8 + (col >> 8)] * (1.0f / 256.0f) + EPS);
        bf16_t* p = Y + (size_t)row * DIN + col; const u32x4 v = *(const u32x4*)p; const f32x4 g0 = *(const f32x4*)(ng + col), g1 = *(const f32x4*)(ng + col + 4);
        u32x4 w; w.x = cvt_pk_bf16(bflo(v.x) * rstd * g0[0], bfhi(v.x) * rstd * g0[1]); w.y = cvt_pk_bf16(bflo(v.y) * rstd * g0[2], bfhi(v.y) * rstd * g0[3]);
        w.z = cvt_pk_bf16(bflo(v.z) * rstd * g1[0], bfhi(v.z) * rstd * g1[1]); w.w = cvt_pk_bf16(bflo(v.w) * rstd * g1[2], bfhi(v.w) * rstd * g1[3]);
        *(u32x4*)p = w;
    }
}

#define MFMA32(a, b, c) __builtin_amdgcn_mfma_f32_32x32x16_bf16((a), (b), (c), 0, 0, 0)
#define MFMA16(a, b, c) __builtin_amdgcn_mfma_f32_16x16x32_bf16((a), (b), (c), 0, 0, 0)
DI int crow(int r, int hi) { return (r & 3) + 8 * (r >> 2) + 4 * hi; }
DI bf16x8 pack8(float a0, float a1, float a2, float a3, float a4, float a5, float a6, float a7) {
    u32x4 p; p.x = cvt_pk_bf16(a0, a1); p.y = cvt_pk_bf16(a2, a3); p.z = cvt_pk_bf16(a4, a5); p.w = cvt_pk_bf16(a6, a7); return __builtin_bit_cast(bf16x8, p);
}
DI void attn_phase(LAS unsigned char* lds, const bf16_t* Q, bf16_t* O, const bf16_t* Kb, const bf16_t* VT, const float* sinks, int vcu, int G) {
    const int tid = threadIdx.x, lane = tid & 63, w = __builtin_amdgcn_readfirstlane(tid >> 6), r = lane & 31, h = lane >> 5;
    constexpr int KST = 144, VST = 1168, KBYTES = 576 * KST;
    LAS unsigned char* Ks = lds; LAS unsigned char* Vs = lds + KBYTES;
    for (int u = vcu; u < 1088; u += G) {
        int b, g, q0, nk; bool isctx;
        if (u < 1024) { b = u >> 8; g = (u >> 6) & 3; q0 = (u & 63) * 64; nk = 576; isctx = false; }
        else { const int uc = u - 1024; b = uc >> 4; g = (uc >> 2) & 3; q0 = (uc & 3) * 64; nk = 256; isctx = true; }
#pragma unroll 3
        for (int c = tid; c < nk * 8; c += 512) {
            const int s = c >> 3, part = c & 7; size_t grow; bool ok = true;
            if (s < 256) grow = (size_t)ML + b * 256 + s; else { const int pos = q0 - 128 + (s - 256); ok = pos >= 0 && pos < SEQ; grow = (size_t)b * SEQ + pos; }
            u32x4 v = (u32x4){0u, 0u, 0u, 0u}; if (ok) v = *(const u32x4*)(Kb + grow * 256 + g * 64 + part * 8);
            *(LAS u32x4*)(Ks + s * KST + part * 16) = v;
        }
        const int cpr = nk >> 3;
#pragma unroll 3
        for (int c = tid; c < 64 * cpr; c += 512) {
            const int d = c / cpr, s = (c - d * cpr) * 8; int pos; bool ok = true;
            if (s < 256) pos = 4096 + s; else { pos = q0 - 128 + (s - 256); ok = pos >= 0 && pos < SEQ; }
            u32x4 v = (u32x4){0u, 0u, 0u, 0u}; if (ok) v = *(const u32x4*)(VT + (size_t)((b * 4 + g) * 64 + d) * VTP + pos);
            *(LAS u32x4*)(Vs + d * VST + s * 2) = v;
        }
        const int hq = g * 4 + (w >> 1), ql = 32 * (w & 1) + r;
        const size_t qrow = (isctx ? (size_t)ML + b * 256 : (size_t)b * SEQ) + q0 + ql;
        bf16x8 qf[4];
#pragma unroll
        for (int d0 = 0; d0 < 4; ++d0) qf[d0] = *(const bf16x8*)(Q + qrow * 1024 + hq * 64 + d0 * 16 + h * 8);
        __syncthreads();
        float m_run = sinks[hq] * LOG2E, l_run = (h == 0) ? 1.f : 0.f;
        f32x16 o0, o1;
#pragma unroll
        for (int i = 0; i < 16; ++i) { o0[i] = 0.f; o1[i] = 0.f; }
        const int qpos = q0 + ql, ntile = nk >> 6;
        for (int kt = 0; kt < ntile; ++kt) {
            f32x16 p0, p1;
#pragma unroll
            for (int i = 0; i < 16; ++i) { p0[i] = 0.f; p1[i] = 0.f; }
            const LAS unsigned char* kb = Ks + (kt * 64 + r) * KST + h * 16;
#pragma unroll
            for (int d0 = 0; d0 < 4; ++d0) {
                const bf16x8 a0 = *(const LAS bf16x8*)(kb + d0 * 32), a1 = *(const LAS bf16x8*)(kb + 32 * KST + d0 * 32);
                p0 = MFMA32(a0, qf[d0], p0); p1 = MFMA32(a1, qf[d0], p1);
            }
            const int pbase_u = q0 - 128 + (kt - 4) * 64;
            if (kt >= 4 && (kt == 4 || kt == 8 || pbase_u < 0 || pbase_u + 64 > SEQ)) {
                const int pbase = pbase_u;
#pragma unroll
                for (int i = 0; i < 16; ++i) {
                    const int k0 = pbase + crow(i, h), k1 = k0 + 32; const int d0 = k0 - qpos, d1 = k1 - qpos;
                    const bool v0 = k0 >= 0 && k0 < SEQ && d0 <= 128 && d0 >= -128, v1 = k1 >= 0 && k1 < SEQ && d1 <= 128 && d1 >= -128;
                    if (!v0) p0[i] = -INFINITY; if (!v1) p1[i] = -INFINITY;
                }
            }
            float mt = p0[0];
#pragma unroll
            for (int i = 1; i < 16; ++i) mt = fmaxf(mt, p0[i]);
#pragma unroll
            for (int i = 0; i < 16; ++i) mt = fmaxf(mt, p1[i]);
            mt = fmaxf(mt, __shfl_xor(mt, 32));
            const float mn = fmaxf(m_run, mt), alpha = __builtin_amdgcn_exp2f(m_run - mn); m_run = mn;
            float ls = 0.f;
#pragma unroll
            for (int i = 0; i < 16; ++i) { p0[i] = __builtin_amdgcn_exp2f(p0[i] - mn); ls += p0[i]; p1[i] = __builtin_amdgcn_exp2f(p1[i] - mn); ls += p1[i]; }
            l_run = l_run * alpha + ls;
            if (__any(alpha != 1.0f)) {
#pragma unroll
                for (int i = 0; i < 16; ++i) { o0[i] *= alpha; o1[i] *= alpha; }
            }
#pragma unroll
            for (int hf = 0; hf < 2; ++hf)
#pragma unroll
                for (int s = 0; s < 2; ++s) {
                    const bf16x8 pb = hf == 0 ? pack8(p0[8 * s], p0[8 * s + 1], p0[8 * s + 2], p0[8 * s + 3], p0[8 * s + 4], p0[8 * s + 5], p0[8 * s + 6], p0[8 * s + 7])
                                              : pack8(p1[8 * s], p1[8 * s + 1], p1[8 * s + 2], p1[8 * s + 3], p1[8 * s + 4], p1[8 * s + 5], p1[8 * s + 6], p1[8 * s + 7]);
                    const int kk = kt * 64 + 32 * hf + 16 * s + 4 * h;
                    { const LAS unsigned char* vp = Vs + r * VST + kk * 2; const s16x4 lo = *(const LAS s16x4*)vp, hi = *(const LAS s16x4*)(vp + 16);
                      o0 = MFMA32(__builtin_shufflevector(lo, hi, 0, 1, 2, 3, 4, 5, 6, 7), pb, o0); }
                    { const LAS unsigned char* vp = Vs + (32 + r) * VST + kk * 2; const s16x4 lo = *(const LAS s16x4*)vp, hi = *(const LAS s16x4*)(vp + 16);
                      o1 = MFMA32(__builtin_shufflevector(lo, hi, 0, 1, 2, 3, 4, 5, 6, 7), pb, o1); }
                }
        }
        const float inv = 1.0f / (l_run + __shfl_xor(l_run, 32));
        bf16_t* op = O + qrow * 1024 + hq * 64 + 4 * h;
#pragma unroll
        for (int gi = 0; gi < 4; ++gi) {
            u32x2 a; a.x = cvt_pk_bf16(o0[4 * gi] * inv, o0[4 * gi + 1] * inv); a.y = cvt_pk_bf16(o0[4 * gi + 2] * inv, o0[4 * gi + 3] * inv); *(u32x2*)(op + 8 * gi) = a;
            u32x2 c; c.x = cvt_pk_bf16(o1[4 * gi] * inv, o1[4 * gi + 1] * inv); c.y = cvt_pk_bf16(o1[4 * gi + 2] * inv, o1[4 * gi + 3] * inv); *(u32x2*)(op + 32 + 8 * gi) = c;
        }
        __syncthreads();
    }
}

typedef short v4i16_t __attribute__((ext_vector_type(4)));
DI s16x4 tr4(const LAS unsigned char* p) { return __builtin_bit_cast(s16x4, __builtin_amdgcn_ds_read_tr16_b64_v4i16((LAS v4i16_t*)p)); }
constexpr int S_BM = 0, S_CM = 34816, S_XS = 69632, S_XW = 79872, S_HB = 90112, S_AR = 98816, AR_BYTES = 4160, S_CW = S_AR + 2 * AR_BYTES;
struct CW8 { float w0[8], w1[8], w2[8], bs[8]; };
DI void cw_load(CW8& c, const LAS float* cw) {
    *(f32x4*)&c.w0[0] = *(const LAS f32x4*)(cw); *(f32x4*)&c.w0[4] = *(const LAS f32x4*)(cw + 4);
    *(f32x4*)&c.w1[0] = *(const LAS f32x4*)(cw + 8); *(f32x4*)&c.w1[4] = *(const LAS f32x4*)(cw + 12);
    *(f32x4*)&c.w2[0] = *(const LAS f32x4*)(cw + 16); *(f32x4*)&c.w2[4] = *(const LAS f32x4*)(cw + 20);
    *(f32x4*)&c.bs[0] = *(const LAS f32x4*)(cw + 24); *(f32x4*)&c.bs[4] = *(const LAS f32x4*)(cw + 28);
}
DI void conv8(const u32x4& vm, const u32x4& v0, const u32x4& vp, const CW8& c, float* o) {
    const unsigned am[4] = {vm.x, vm.y, vm.z, vm.w}, a0[4] = {v0.x, v0.y, v0.z, v0.w}, ap[4] = {vp.x, vp.y, vp.z, vp.w};
#pragma unroll
    for (int e = 0; e < 4; ++e) {
        const float lo = c.bs[2 * e] + c.w0[2 * e] * bflo(am[e]) + c.w1[2 * e] * bflo(a0[e]) + c.w2[2 * e] * bflo(ap[e]);
        const float hi = c.bs[2 * e + 1] + c.w0[2 * e + 1] * bfhi(am[e]) + c.w1[2 * e + 1] * bfhi(a0[e]) + c.w2[2 * e + 1] * bfhi(ap[e]);
        o[2 * e] = silu_f(lo); o[2 * e + 1] = silu_f(hi);
    }
}

constexpr int CV_SEG = 16, CV_ITEMS = (MT / CV_SEG) * 8, CV_MAXK = 5;
struct ConvHalo { u32x4 top[CV_MAXK], bot[CV_MAXK]; };
DI void conv_bounds(int r0, int& lo, int& hi) { if (r0 < ML) { lo = r0 & ~4095; hi = lo + SEQ; } else { lo = ML + ((r0 - ML) & ~255); hi = lo + CTXL; } }
DI void conv_capture(ConvHalo& hh, const bf16_t* X, int gw, int NGW, int lane) {
#pragma unroll
    for (int k = 0; k < CV_MAXK; ++k) {
        const int item = gw + k * NGW; hh.top[k] = (u32x4){0u, 0u, 0u, 0u}; hh.bot[k] = hh.top[k];
        if (item < CV_ITEMS) { const int r0 = (item >> 3) * CV_SEG, ch = (item & 7) * 512 + lane * 8; int lo, hi; conv_bounds(r0, lo, hi);
            if (r0 > lo) hh.top[k] = *(const u32x4*)(X + (size_t)(r0 - 1) * NXBC + ch);
            if (r0 + CV_SEG < hi) hh.bot[k] = *(const u32x4*)(X + (size_t)(r0 + CV_SEG) * NXBC + ch); }
    }
}
DI void conv_apply(const ConvHalo& hh, bf16_t* X, const float* conv_w, const float* conv_b, int gw, int NGW, int lane) {
#pragma unroll
    for (int k = 0; k < CV_MAXK; ++k) {
        const int item = gw + k * NGW;
        if (item < CV_ITEMS) {
            const int r0 = (item >> 3) * CV_SEG, ch = (item & 7) * 512 + lane * 8;
            bf16_t* xp = X + (size_t)r0 * NXBC + ch;
            u32x4 rows[CV_SEG + 2]; rows[0] = hh.top[k]; rows[CV_SEG + 1] = hh.bot[k];
#pragma unroll
            for (int t = 0; t < CV_SEG; ++t) rows[t + 1] = *(const u32x4*)(xp + (size_t)t * NXBC);
            CW8 c;
            *(f32x4*)&c.w0[0] = *(const f32x4*)(conv_w + ch); *(f32x4*)&c.w0[4] = *(const f32x4*)(conv_w + ch + 4);
            *(f32x4*)&c.w1[0] = *(const f32x4*)(conv_w + 4096 + ch); *(f32x4*)&c.w1[4] = *(const f32x4*)(conv_w + 4096 + ch + 4);
            *(f32x4*)&c.w2[0] = *(const f32x4*)(conv_w + 8192 + ch); *(f32x4*)&c.w2[4] = *(const f32x4*)(conv_w + 8192 + ch + 4);
            *(f32x4*)&c.bs[0] = *(const f32x4*)(conv_b + ch); *(f32x4*)&c.bs[4] = *(const f32x4*)(conv_b + ch + 4);
#pragma unroll
            for (int t = 0; t < CV_SEG; ++t) { float o[8]; conv8(rows[t], rows[t + 1], rows[t + 2], c, o);
                u32x4 pk; pk.x = cvt_pk_bf16(o[0], o[1]); pk.y = cvt_pk_bf16(o[2], o[3]); pk.z = cvt_pk_bf16(o[4], o[5]); pk.w = cvt_pk_bf16(o[6], o[7]);
                *(u32x4*)(xp + (size_t)t * NXBC) = pk; }
        }
    }
}
constexpr int G_BM = 0, G_CM = 17408, G_XS = 34816, G_XW = 39936, G_HB = 45056, G_AR = 53760, G_ARB = 2176, G_SZ = 58368;
DI void ssd_chunk64(int b, int dir, int st, int& row0, bool& lat, int& kk) {
    if (st < 4) { const int c = dir ? 3 - st : st; row0 = ML + b * 256 + 64 * c; lat = false; kk = 0; }
    else { kk = dir ? 67 - st : st - 4; row0 = b * SEQ + 64 * kk; lat = true; }
}
DI void ssd_scan64(LAS float* AR, bool fwdarr, bool own, int lane, float d, float A) {
    const float a = d * A; float incl = a;
#pragma unroll
    for (int o = 1; o < 64; o <<= 1) { const float v = __shfl_up(incl, o); if (lane >= o) incl += v; }
    const float tot = __shfl(incl, 63);
    if (fwdarr) {
        const float c = incl; const float cr = __shfl(c, (lane & ~15) | 15);
        AR[lane] = c; AR[128 + lane] = d; AR[384 + lane] = __expf(cr - c) * d;
        if (own) { AR[256 + lane] = __expf(tot - c) * d; AR[320 + lane] = __expf(c); if (lane == 0) AR[512] = __expf(tot); }
    } else {
        const float c = tot - (incl - a); const float cr = __shfl(c, lane & ~15);
        AR[64 + lane] = c; AR[192 + lane] = d; AR[448 + lane] = __expf(cr - c) * d;
        if (own) { AR[256 + lane] = __expf(tot - c) * d; AR[320 + lane] = __expf(c); if (lane == 0) AR[512] = __expf(tot); }
    }
}
DI void ssd_phase(LAS unsigned char* lds0, const bf16_t* XBC, const float* DT, bf16_t* Y, const float* A_log, const float* Dsk, int vcu, int G) {
    const int tid = threadIdx.x, lane = tid & 63, w = __builtin_amdgcn_readfirstlane(tid >> 6), fr = lane & 15, fq = lane >> 4, qq = (lane & 15) >> 2, pp = lane & 3;
    const int dir = w >> 2, wl = w & 3, gtid = tid & 255;
    LAS unsigned char* lds = lds0 + dir * G_SZ;
    const int chgrp = gtid & 15, rb = gtid >> 4, chg = gtid & 3, tx = gtid >> 2;
    const bool scanF = (dir == 0 && wl == 0), scanB = (dir == 0 && wl == 1) || (dir == 1 && wl == 0), scanner = scanF || scanB;
    for (int u = vcu; u < 256; u += G) {
        const int b = u >> 6, g = (u >> 3) & 7, hd = g * 4 + ((u >> 1) & 3), ph = u & 1;
        const float Af = -__expf(A_log[hd]), Ab = -__expf(A_log[32 + hd]), Dv = Dsk[hd];
        const int xch = hd * 64 + ph * 32;
        const int chB = 2048 + g * 128 + chgrp * 8, chC = chB + 1024, chX = xch + chg * 8;
        const float Aw = scanF ? Af : Ab; const int dcol = (scanF ? 0 : 32) + hd;
        f32x4 H[2][2];
#pragma unroll
        for (int pt = 0; pt < 2; ++pt) { H[pt][0] = (f32x4){0.f, 0.f, 0.f, 0.f}; H[pt][1] = H[pt][0]; }
        int row0, kk; bool lat;
        ssd_chunk64(b, dir, 0, row0, lat, kk);
        u32x4 vB[4], vC[4], vX;
#pragma unroll
        for (int q = 0; q < 4; ++q) { vB[q] = *(const u32x4*)(XBC + (size_t)(row0 + 4 * rb + q) * NXBC + chB); vC[q] = *(const u32x4*)(XBC + (size_t)(row0 + 4 * rb + q) * NXBC + chC); }
        vX = *(const u32x4*)(XBC + (size_t)(row0 + tx) * NXBC + chX);
        __syncthreads();
        if (scanner) ssd_scan64((LAS float*)(lds + G_AR), scanF, (dir == 0) == scanF, lane, DT[(size_t)(row0 + lane) * 64 + dcol], Aw);
        for (int st = 0; st < 68; ++st) {
            LAS float* AR = (LAS float*)(lds + G_AR + (st & 1) * G_ARB);
            LAS float* CF = AR; LAS float* CBK = AR + 64; LAS float* DTF = AR + 128; LAS float* DTB = AR + 192; LAS float* WST = AR + 256; LAS float* ECUM = AR + 320; LAS float* E2F = AR + 384; LAS float* E2B = AR + 448;
            const bool curlat = lat, need_diag = lat && dir == 0; const int currow0 = row0;
            const bool first = dir == 0 ? kk <= 31 : kk >= 32;
            asm volatile("s_waitcnt vmcnt(0)" ::: "memory");
            __syncthreads();
#pragma unroll
            for (int pt = 0; pt < 2; ++pt)
#pragma unroll
                for (int n2 = 0; n2 < 2; ++n2)
#pragma unroll
                    for (int jj = 0; jj < 4; ++jj) *(LAS bf16_t*)(lds + G_HB + (16 * pt + 4 * fq + jj) * 272 + (16 * (2 * wl + n2) + fr) * 2) = (bf16_t)(cvt_pk_bf16(H[pt][n2][jj], 0.f) & 0xffffu);
            const float ws_ = WST[tx];
#pragma unroll
            for (int q = 0; q < 4; ++q) { *(LAS u32x4*)(lds + G_BM + (4 * rb + q) * 272 + chgrp * 16) = vB[q]; *(LAS u32x4*)(lds + G_CM + (4 * rb + q) * 272 + chgrp * 16) = vC[q]; }
            { *(LAS u32x4*)(lds + G_XS + tx * 80 + chg * 16) = vX;
                u32x4 pk; pk.x = cvt_pk_bf16(bflo(vX.x) * ws_, bfhi(vX.x) * ws_); pk.y = cvt_pk_bf16(bflo(vX.y) * ws_, bfhi(vX.y) * ws_);
                pk.z = cvt_pk_bf16(bflo(vX.z) * ws_, bfhi(vX.z) * ws_); pk.w = cvt_pk_bf16(bflo(vX.w) * ws_, bfhi(vX.w) * ws_);
                *(LAS u32x4*)(lds + G_XW + tx * 80 + chg * 16) = pk; }
            __syncthreads();
            const int il = 16 * wl + fr;
            u32x2 yo0 = (u32x2){0u, 0u}, yo1 = yo0;
            if (curlat && !first) { const bf16_t* yp = Y + (size_t)(currow0 + il) * DIN + xch + 4 * fq; yo0 = *(const u32x2*)yp; yo1 = *(const u32x2*)(yp + 16); }
            float dn = 0.f;
            if (st + 1 < 68) {
                ssd_chunk64(b, dir, st + 1, row0, lat, kk);
#pragma unroll
                for (int q = 0; q < 4; ++q) { vB[q] = *(const u32x4*)(XBC + (size_t)(row0 + 4 * rb + q) * NXBC + chB); vC[q] = *(const u32x4*)(XBC + (size_t)(row0 + 4 * rb + q) * NXBC + chC); }
                vX = *(const u32x4*)(XBC + (size_t)(row0 + tx) * NXBC + chX);
                if (scanner) dn = DT[(size_t)(row0 + lane) * 64 + dcol];
            }
            bf16x8 cfr[4];
#pragma unroll
            for (int ks = 0; ks < 4; ++ks) cfr[ks] = *(const LAS bf16x8*)(lds + G_CM + il * 272 + (32 * ks + 8 * fq) * 2);
            f32x4 yacc[2]; yacc[0] = (f32x4){0.f, 0.f, 0.f, 0.f}; yacc[1] = yacc[0];
            if (need_diag) {
                const float cfi = CF[il], cbi = CBK[il];
                f32x4 ga[4];
#pragma unroll
                for (int jt = 0; jt < 4; ++jt) ga[jt] = (f32x4){0.f, 0.f, 0.f, 0.f};
#pragma unroll
                for (int ks = 0; ks < 4; ++ks) {
                    bf16x8 bfr[4];
#pragma unroll
                    for (int jt = 0; jt < 4; ++jt) bfr[jt] = *(const LAS bf16x8*)(lds + G_BM + (16 * jt + fr) * 272 + (32 * ks + 8 * fq) * 2);
#pragma unroll
                    for (int jt = 0; jt < 4; ++jt) ga[jt] = MFMA16(bfr[jt], cfr[ks], ga[jt]);
                }
                bf16x8 mfr[2];
#pragma unroll
                for (int uu = 0; uu < 2; ++uu) {
                    float val[8];
#pragma unroll
                    for (int hf = 0; hf < 2; ++hf) {
                        const int jt = 2 * uu + hf; const int j0 = 16 * jt + 4 * fq;
                        if (jt < wl) {
                            const float e1 = __expf(cfi - CF[16 * jt + 15]); const f32x4 e2 = *(const LAS f32x4*)(E2F + j0);
#pragma unroll
                            for (int jj = 0; jj < 4; ++jj) val[hf * 4 + jj] = ga[jt][jj] * (e1 * e2[jj]);
                        } else if (jt > wl) {
                            const float e1 = __expf(cbi - CBK[16 * jt]); const f32x4 e2 = *(const LAS f32x4*)(E2B + j0);
#pragma unroll
                            for (int jj = 0; jj < 4; ++jj) val[hf * 4 + jj] = ga[jt][jj] * (e1 * e2[jj]);
                        } else {
                            const f32x4 cfj = *(const LAS f32x4*)(CF + j0), cbj = *(const LAS f32x4*)(CBK + j0), dfj = *(const LAS f32x4*)(DTF + j0), dbj = *(const LAS f32x4*)(DTB + j0);
#pragma unroll
                            for (int jj = 0; jj < 4; ++jj) { const int j = j0 + jj;
                                const float mf = (j <= il) ? __expf(fminf(cfi - cfj[jj], 0.f)) * dfj[jj] : 0.f;
                                const float mb = (j >= il) ? __expf(fminf(cbi - cbj[jj], 0.f)) * dbj[jj] : 0.f;
                                val[hf * 4 + jj] = ga[jt][jj] * (mf + mb); }
                        }
                    }
                    mfr[uu] = pack8(val[0], val[1], val[2], val[3], val[4], val[5], val[6], val[7]);
                }
                bf16x8 xfr[2][2];
#pragma unroll
                for (int pt = 0; pt < 2; ++pt)
#pragma unroll
                    for (int uu = 0; uu < 2; ++uu) {
                        const s16x4 lo = tr4(lds + G_XS + (32 * uu + 4 * fq + qq) * 80 + pt * 32 + pp * 8), hi = tr4(lds + G_XS + (32 * uu + 16 + 4 * fq + qq) * 80 + pt * 32 + pp * 8);
                        xfr[pt][uu] = __builtin_shufflevector(lo, hi, 0, 1, 2, 3, 4, 5, 6, 7);
                    }
#pragma unroll
                for (int uu = 0; uu < 2; ++uu)
#pragma unroll
                    for (int pt = 0; pt < 2; ++pt) yacc[pt] = MFMA16(xfr[pt][uu], mfr[uu], yacc[pt]);
            }
            if (curlat) {
                const float ec = ECUM[il];
#pragma unroll
                for (int pt = 0; pt < 2; ++pt) {
                    f32x4 oa = (f32x4){0.f, 0.f, 0.f, 0.f};
                    bf16x8 hfr[4];
#pragma unroll
                    for (int ks = 0; ks < 4; ++ks) hfr[ks] = *(const LAS bf16x8*)(lds + G_HB + (16 * pt + fr) * 272 + (32 * ks + 8 * fq) * 2);
#pragma unroll
                    for (int ks = 0; ks < 4; ++ks) oa = MFMA16(hfr[ks], cfr[ks], oa);
                    f32x4 yv = yacc[pt] + oa * ec;
                    if (dir == 0) { const u32x2 xv = *(const LAS u32x2*)(lds + G_XS + il * 80 + (16 * pt + 4 * fq) * 2);
                        yv[0] += Dv * bflo(xv.x); yv[1] += Dv * bfhi(xv.x); yv[2] += Dv * bflo(xv.y); yv[3] += Dv * bfhi(xv.y); }
                    if (!first) { const u32x2 old = pt == 0 ? yo0 : yo1; yv[0] += bflo(old.x); yv[1] += bfhi(old.x); yv[2] += bflo(old.y); yv[3] += bfhi(old.y); }
                    u32x2 o; o.x = cvt_pk_bf16(yv[0], yv[1]); o.y = cvt_pk_bf16(yv[2], yv[3]);
                    *(u32x2*)(Y + (size_t)(currow0 + il) * DIN + xch + 16 * pt + 4 * fq) = o;
                }
            }
            { const float dec = AR[512];
#pragma unroll
              for (int pt = 0; pt < 2; ++pt) { H[pt][0] = H[pt][0] * dec; H[pt][1] = H[pt][1] * dec; } }
            {
                bf16x8 bq[2][2], xq[2][2];
#pragma unroll
                for (int ks = 0; ks < 2; ++ks) {
#pragma unroll
                    for (int n2 = 0; n2 < 2; ++n2) {
                        const s16x4 blo = tr4(lds + G_BM + (32 * ks + 8 * fq + qq) * 272 + (2 * wl + n2) * 32 + pp * 8), bhi = tr4(lds + G_BM + (32 * ks + 8 * fq + 4 + qq) * 272 + (2 * wl + n2) * 32 + pp * 8);
                        bq[n2][ks] = __builtin_shufflevector(blo, bhi, 0, 1, 2, 3, 4, 5, 6, 7);
                    }
#pragma unroll
                    for (int pt = 0; pt < 2; ++pt) {
                        const s16x4 lo = tr4(lds + G_XW + (32 * ks + 8 * fq + qq) * 80 + pt * 32 + pp * 8), hi = tr4(lds + G_XW + (32 * ks + 8 * fq + 4 + qq) * 80 + pt * 32 + pp * 8);
                        xq[pt][ks] = __builtin_shufflevector(lo, hi, 0, 1, 2, 3, 4, 5, 6, 7);
                    }
                }
#pragma unroll
                for (int ks = 0; ks < 2; ++ks)
#pragma unroll
                    for (int pt = 0; pt < 2; ++pt)
#pragma unroll
                        for (int n2 = 0; n2 < 2; ++n2) H[pt][n2] = MFMA16(xq[pt][ks], bq[n2][ks], H[pt][n2]);
            }
            if (st + 1 < 68 && scanner) ssd_scan64((LAS float*)(lds + G_AR + ((st + 1) & 1) * G_ARB), scanF, (dir == 0) == scanF, lane, dn, Aw);
        }
        asm volatile("s_waitcnt vmcnt(0)" ::: "memory");
        __syncthreads();
    }
}

#define XB_TMO      128
#define XB_XCNT(j)  (256  + 64 * (j))
#define XB_XSUB(j)  (1280 + 64 * (j))
#define XB_XGEN(j)  (2304 + 64 * (j))
#define XB_TOP      3328
#define XB_TOPGEN   3392
#define XCD_BAR_WORDS 3456
#define XB_SPIN_CAP (1u << 18)

__device__ __forceinline__ unsigned xb_ld(unsigned* p)              { return __hip_atomic_load(p, __ATOMIC_RELAXED, __HIP_MEMORY_SCOPE_AGENT); }
__device__ __forceinline__ unsigned xb_add(unsigned* p, unsigned v) { return __hip_atomic_fetch_add(p, v, __ATOMIC_RELAXED, __HIP_MEMORY_SCOPE_AGENT); }
__device__ __forceinline__ unsigned xb_xcc_id() { return (unsigned)__builtin_amdgcn_s_getreg((3 << 11) | 20) & 0xFu; }
#define XB_SPIN(cond, bar) do { unsigned _sp = 0; while (cond) { __builtin_amdgcn_s_sleep(1); \
    if ((++_sp & 255u) == 0u) { if (xb_ld(&(bar)[XB_TMO])) break; if (_sp > XB_SPIN_CAP) { atomicAdd(&(bar)[XB_TMO], 1u); break; } } } } while (0)

struct XcdBarrier {
    unsigned* bar; unsigned x;
    volatile LAS unsigned* st;
};

__device__ __forceinline__ XcdBarrier xcd_barrier_post(unsigned* bar, volatile LAS unsigned* st) {
    XcdBarrier b; b.bar = bar; b.x = xb_xcc_id(); b.st = st;
    if (threadIdx.x == 0) (void)xb_add(&bar[XB_XCNT(b.x)], 1u);
    return b;
}
__device__ __forceinline__ void xcd_barrier_complete(unsigned* bar, unsigned x, unsigned& nloc, unsigned& nx) {
    const unsigned G = gridDim.x * gridDim.y * gridDim.z;
    unsigned sum, cnt, mine, sp = 0u;
    for (;;) {
        sum = 0u; cnt = 0u; mine = 0u;
#pragma unroll
        for (unsigned j = 0; j < 16; ++j) { const unsigned c = xb_ld(&bar[XB_XCNT(j)]); sum += c; cnt += (c > 0u) ? 1u : 0u; mine = (j == x) ? c : mine; }
        if (sum == G) break;
        __builtin_amdgcn_s_sleep(1);
        if ((++sp & 255u) == 0u) { if (xb_ld(&bar[XB_TMO])) break; if (sp > XB_SPIN_CAP) { atomicAdd(&bar[XB_TMO], 1u); break; } }
    }
    nloc = mine > 0u ? mine : 1u; nx = cnt > 0u ? cnt : 1u;
}

__device__ __forceinline__ void xcd_barrier(const XcdBarrier& b) {
    asm volatile("s_waitcnt vmcnt(0)" ::: "memory");
    __syncthreads();
    if (threadIdx.x == 0) {
        unsigned* bar = b.bar;
        __builtin_amdgcn_s_waitcnt(0);
        unsigned nloc = b.st[0], nx = b.st[1];
        if (nloc == 0u) { xcd_barrier_complete(bar, b.x, nloc, nx); b.st[0] = nloc; b.st[1] = nx; }
        const unsigned old = xb_add(&bar[XB_XSUB(b.x)], 1u);
        const unsigned gen = old / nloc;
        if (old + 1u == (gen + 1u) * nloc) {
            __builtin_amdgcn_fence(__ATOMIC_RELEASE, "agent");
            asm volatile("s_waitcnt vmcnt(0)" ::: "memory");
            const unsigned og = xb_add(&bar[XB_TOP], 1u);
            const unsigned tg = og / nx;
            if (og + 1u == (tg + 1u) * nx) xb_add(&bar[XB_TOPGEN], 1u);
            else XB_SPIN(xb_ld(&bar[XB_TOPGEN]) == tg, bar);
            __builtin_amdgcn_fence(__ATOMIC_ACQUIRE, "agent");
            xb_add(&bar[XB_XGEN(b.x)], 1u);
            asm volatile("s_waitcnt vmcnt(0)" ::: "memory");
        } else {
            XB_SPIN(xb_ld(&bar[XB_XGEN(b.x)]) == gen, bar);
            __builtin_amdgcn_fence(__ATOMIC_ACQUIRE, "agent");
            asm volatile("s_waitcnt vmcnt(0)" ::: "memory");
        }
    }
    __syncthreads();
}

constexpr int NPHASE = 18;
#define DUPMASK 0x4
#define DUP(k) ((DUPMASK >> (k)) & 1)
#define REP_ATT 1
#define REP_SSD 1
#define REP_GEMM 1
#define REP_NORM 1
#define XSYNC 0
#ifndef PHMASK
#define PHMASK 0x3ffff
#endif
#define PHON(k) ((PHMASK >> (k)) & 1)
template <bool COOP>
__global__ void __launch_bounds__(512) mega(Params P) {
    extern __shared__ __attribute__((aligned(16))) unsigned char lds_raw[];
    LAS unsigned char* lds = (LAS unsigned char*)lds_raw;
    const int tid = threadIdx.x, lane = tid & 63, wave = __builtin_amdgcn_readfirstlane(tid >> 6);
    const int G = gridDim.x; const int bx = blockIdx.x; const int vcu = (G % 8 == 0) ? (bx % 8) * (G / 8) + bx / 8 : bx;
    const int gw = vcu * 8 + wave, NGW = G * 8;
    unsigned char* ws = P.ws;
#define MOD ((float*)(P.ws + WS_MOD))
#define rope ((const float*)(P.ws + WS_ROPE))
#define CTXR ((float*)(P.ws + WS_CTXR))
#define HN ((bf16_t*)(P.ws + WS_HN))
#define DTb ((float*)(P.ws + WS_DT))
#define x_in (P.in[0])
#define ctx_in (P.in[2])
#define xo (P.out)
    const int lo = P.ph_lo, hi = P.ph_hi;
    volatile LAS unsigned* xst = (volatile LAS unsigned*)(lds + 159984);
    if (tid < 2) xst[tid] = 0u;
    __syncthreads();
    XcdBarrier xb = xcd_barrier_post((unsigned*)(ws + WS_BAR), xst);
    if (hi > 1000) cg::this_grid().sync();
#define IN(k) (PHON(k) && lo <= (k) && (k) < hi)
#define SYNC(k) do { if ((k) + 1 < hi) { xcd_barrier(xb); } } while (0)
#define NORM_PH(k, layer, second, xL, xC, nrows, NS_, goff_) if (IN(k)) { \
        const CtxPart cp{(const float*)(ws + WS_PARTA), (const float*)(ws + WS_PARTB), MOD + 4 * 6144 + (goff_), CTXR, NS_}; \
        for (int rep = 0; rep < REP_NORM; ++rep) norm_phase(xL, xC, ((second) ? P.in[7] : P.in[6]) + (layer) * 1024, MOD + (layer) * 5 * 6144, (second) ? 3072 : 0, (second) ? 4096 : 1024, HN, nrows, gw, NGW, lane, cp); SYNC(k); }
#define RES_PH(k, Aoff, Boff, M_, K_, bL, bC, goff) if (IN(k)) { \
        pg8::Gemm gm{(const bf16_t*)(ws + (Aoff)), (const bf16_t*)(ws + (Boff)), M_, 1024, K_, K_}; pg8::StaticOrder S; S.init(M_, 1024, G, bx); \
        EpiRes E{bL, bC, xo, CTXR, MOD + (goff)}; pg8::gemm_phase<EpiRes, pg8::StaticOrder, true, true>(lds, gm, S, E); if ((k) != 4 && (k) != 7) SYNC(k); }
#define RESCTX_PH(k, Aoff, Boff, K_, NS) if (IN(k)) { \
        pg8::Gemm gm{(const bf16_t*)(ws + (Aoff)), (const bf16_t*)(ws + (Boff)), MT, 1024, (K_) / (NS), K_}; pg8::SplitOrder S{64, 4, 4, NS, G, bx}; \
        EpiPart E{(float*)(ws + WS_PARTA), (float*)(ws + WS_PARTB)}; pg8::gemm_phase<EpiPart, pg8::SplitOrder, true, true>(lds, gm, S, E); SYNC(k); }
#define SWI_PH(k, Boff, Hoff, M_) if (IN(k)) { \
        pg8::Gemm gm{HN, (const bf16_t*)(ws + (Boff)), M_, 2 * DFF, 1024, 1024}; pg8::StaticOrder S; S.init(M_, 2 * DFF, G, bx); \
        EpiSwi E{(bf16_t*)(ws + (Hoff))}; for (int rep = 0; rep < REP_GEMM; ++rep) pg8::gemm_phase<EpiSwi, pg8::StaticOrder, true, true>(lds, gm, S, E); SYNC(k); }

    if (IN(0)) { phase0(P, lds, vcu, G); SYNC(0); for (int rep = 0; rep < XSYNC; ++rep) xcd_barrier(xb); }
    NORM_PH(1, 0, false, x_in, ctx_in, MT, 0, 0)
    if (IN(2)) {
        pg8::Gemm gm{HN, (const bf16_t*)(ws + WS_WQKV), MT, 1536, 1024, 1024}; pg8::StaticOrder S; S.init(MT, 1536, G, bx);
        EpiQKV E{(bf16_t*)(ws + WS_Q), (bf16_t*)(ws + WS_K), (bf16_t*)(ws + WS_VT), rope};
        for (int rep = 0; rep < REP_GEMM; ++rep) pg8::gemm_phase<EpiQKV, pg8::StaticOrder, true, true>(lds, gm, S, E); SYNC(2);
    }
    if (IN(3)) { for (int rep = 0; rep < REP_ATT; ++rep) attn_phase(lds, (const bf16_t*)(ws + WS_Q), HN, (const bf16_t*)(ws + WS_K), (const bf16_t*)(ws + WS_VT), P.in[10], vcu, G); SYNC(3); }
    RES_PH(4, WS_HN, WS_WO, ML, 1024, x_in, ctx_in, 2048)
    RESCTX_PH(4, WS_HN, WS_WO, 1024, 4)
    NORM_PH(5, 0, true, xo, ctx_in, MT, 4, 2048)
    SWI_PH(6, WS_GU0, WS_HB0, MT)
    RES_PH(7, WS_HB0, WS_DN0, ML, DFF, xo, CTXR, 5120)
    RESCTX_PH(7, WS_HB0, WS_DN0, DFF, 11)
    NORM_PH(8, 1, false, xo, CTXR, MT, 11, 5120)
    if (IN(9)) {
        pg8::Gemm gm{HN, (const bf16_t*)(ws + WS_WXBC), MT, NXBCP, 1024, 1024}; pg8::StaticOrder S; S.init(MT, NXBCP, G, bx);
        EpiXbc E{(bf16_t*)(ws + WS_XBC), DTb, P.in[14]};
        for (int rep = 0; rep < REP_GEMM; ++rep) pg8::gemm_phase<EpiXbc, pg8::StaticOrder, true, true>(lds, gm, S, E); SYNC(9);
    }
    if (IN(10)) {
        { ConvHalo hh; conv_capture(hh, (const bf16_t*)(ws + WS_XBC), gw, NGW, lane);
          xcd_barrier(xb);
          conv_apply(hh, (bf16_t*)(ws + WS_XBC), P.in[12], P.in[13], gw, NGW, lane);
          xcd_barrier(xb); }
        for (int rep = 0; rep < REP_SSD; ++rep) ssd_phase(lds, (const bf16_t*)(ws + WS_XBC), DTb, (bf16_t*)(ws + WS_Y), P.in[15], P.in[16], vcu, G); SYNC(10); }
    if (IN(11)) {
        pg8::Gemm gm{HN, (const bf16_t*)(ws + WS_WZ), ML, DIN, 1024, 1024}; pg8::StaticOrder S; S.init(ML, DIN, G, bx);
        EpiZ E{(bf16_t*)(ws + WS_Y), P.in[17], (LAS float*)(lds + 132096)};
        pg8::gemm_phase<EpiZ, pg8::StaticOrder, true, true>(lds, gm, S, E); SYNC(11);
    }
    RES_PH(13, WS_Y, WS_WOUT, ML, DIN, xo, CTXR, 5 * 6144 + 2048)
    if (IN(14)) phase_conv_ffn1(P, lds, vcu, G);
    NORM_PH(14, 1, true, xo, CTXR, ML, 0, 0)
    SWI_PH(15, WS_GU1, WS_HB1, ML)
    RES_PH(16, WS_HB1, WS_DN1, ML, DFF, xo, CTXR, 5 * 6144 + 5120)
    if (IN(17)) { final_norm_phase(xo, P.in[22], gw, NGW, lane); }
}

extern "C" void kernel_launch(void* const* d_in, const int* in_sizes, int n_in, void* d_out, int out_size, void* d_ws, size_t ws_size, hipStream_t stream) {
    static int grid = 0;
    if (grid == 0) {
        if (n_in != 23 || out_size != ML * DM || ws_size < WS_END) { fprintf(stderr, "kernel_launch: unexpected shapes (n_in %d out %d ws %zu)\n", n_in, out_size, ws_size); grid = -1; return; }
        int dev = 0, cus = 0, per_cu = 0;
        (void)hipGetDevice(&dev); (void)hipDeviceGetAttribute(&cus, hipDeviceAttributeMultiprocessorCount, dev);
        (void)hipFuncSetAttribute((const void*)mega<true>, hipFuncAttributeMaxDynamicSharedMemorySize, LDS_BYTES);
        (void)hipOccupancyMaxActiveBlocksPerMultiprocessor(&per_cu, (const void*)mega<true>, 512, LDS_BYTES);
        if (per_cu < 1) fprintf(stderr, "kernel_launch: occupancy query says %d blocks/CU\n", per_cu);
        (void)hipGetLastError();
        grid = cus >= 256 ? 256 : cus;
        if (grid <= 0) grid = 256;
    }
    if (grid < 0) return;
    (void)hipMemsetAsync((char*)d_ws, 0, CTL_BYTES, stream);
    Params p{};
    for (int i = 0; i < 23; ++i) p.in[i] = (const float*)d_in[i];
    p.out = (float*)d_out; p.ws = (unsigned char*)d_ws;
    p.ph_lo = 0; p.ph_hi = NPHASE;
    void* args[] = {&p};
    hipError_t e = hipLaunchCooperativeKernel((const void*)mega<true>, dim3(grid), dim3(512), args, LDS_BYTES, stream);
    if (e != hipSuccess) fprintf(stderr, "cooperative launch failed: %s (grid %d)\n", hipGetErrorString(e), grid);
}
```

```cpp
#include <hip/hip_runtime.h>
#include <hip/hip_cooperative_groups.h>
#include <cstdio>
#include <cstdint>
namespace cg = cooperative_groups;
namespace pg8 {
#define PG8_LAS __attribute__((address_space(3)))
typedef unsigned short bf16_t;
typedef short bf16x8 __attribute__((ext_vector_type(8)));
typedef float f32x4 __attribute__((ext_vector_type(4)));
typedef unsigned u32x4 __attribute__((ext_vector_type(4)));
constexpr int BM = 256, BK = 64, HALF = 128, HTB = HALF * BK * 2  , STAGE_BYTES = 8 * HTB, NXCD = 8, WGM = 8;

__host__ __device__ __forceinline__ int lds_byte(int r, int c) { const int st = (r >> 4) * 2 + (c >> 5), rr = r & 15, cc = c & 31, ob = rr * 64 + cc * 2; return st * 1024 + (ob ^ (((ob >> 9) & 1) << 5)); }
__host__ __device__ __forceinline__ void stage_rc(int b, int& R, int& C) { const int st = b / 1024, sb = b % 1024, swz = sb ^ (((sb >> 9) & 1) << 5); R = (st >> 1) * 16 + swz / 64; C = (st & 1) * 32 + (swz % 64) / 2; }
__host__ __device__ __forceinline__ int perm32(int rho) { const int n = rho >> 4, i = rho & 15; return 8 * (i >> 2) + 4 * n + (i & 3); }

struct Unit { int pm, pn, pk; };
struct Gemm { const bf16_t* A; const bf16_t* Bt; int M, N, K, ld; };

struct StaticOrder {
    int nM, nN, nwg, G, c;
    __host__ __device__ void init(int M, int N, int G_, int c_) { nM = M / BM; nN = N / BM; nwg = nM * nN; G = G_; c = c_; }
    __host__ __device__ bool next(int i, Unit& u) const {
        const long L = (long)i * G + c; if (L >= nwg) return false;
        int wgid = (int)L; { const int q = nwg / NXCD, r = nwg % NXCD, xcd = wgid % NXCD, off = wgid / NXCD; wgid = (xcd < r ? xcd * (q + 1) : r * (q + 1) + (xcd - r) * q) + off; }
        const int nig = WGM * nN, gid = wgid / nig, fm = gid * WGM, gsz = (nM - fm) < WGM ? (nM - fm) : WGM;
        u.pm = fm + ((wgid % nig) % gsz); u.pn = (wgid % nig) / gsz; u.pk = 0; return true;
    }
    __device__ __forceinline__ void a_ready(const Unit&) const {}
    __device__ __forceinline__ void done(const Unit&) const {}
};
struct SplitOrder {
    int pm0, npm, nN, ns, G, c;
    __host__ __device__ bool next(int i, Unit& u) const { const int L = i * G + c; if (L >= npm * nN * ns) return false; u.pk = L % ns; const int r = L / ns; u.pn = r % nN; u.pm = pm0 + r / nN; return true; }
    __device__ __forceinline__ void a_ready(const Unit&) const {}
    __device__ __forceinline__ void done(const Unit&) const {}
};
__device__ __forceinline__ unsigned cvt_pk_bf16(float lo, float hi) { unsigned r; asm volatile("v_cvt_pk_bf16_f32 %0, %1, %2" : "=v"(r) : "v"(lo), "v"(hi)); return r; }
template <class Epi, class Sched, bool ALIGN_EPI = false, bool SP2 = false>
__device__ __forceinline__ void gemm_phase(PG8_LAS unsigned char* lds, const Gemm g, const Sched& S, const Epi& E) {
    const int tid = threadIdx.x, wid = __builtin_amdgcn_readfirstlane(tid >> 6), lane = tid & 63, wr = wid >> 2, wc = wid & 3, fr = lane & 15, fq = lane >> 4;
    const int K = g.K, nt = K / BK, LD = g.ld;
    unsigned voffA[2], voffB[2];
#pragma unroll
    for (int i = 0; i < 2; ++i) { int R, C; stage_rc(tid * 16 + i * 8192, R, C); const int Rb = Epi::PERM ? ((R & ~31) + perm32(R & 31)) : R;
        voffA[i] = (unsigned)(R * LD + C) * 2u; voffB[i] = (unsigned)(Rb * LD + C) * 2u; }
    const size_t kstep = (size_t)(BK * 2);
    const size_t hstep = (size_t)HALF * LD * 2;
    const size_t tstep = 2 * hstep;
    const unsigned ldsw = (unsigned)wid * 1024u;
    const int aoff = lds_byte(wr * 64 + fr, fq * 8), boff = lds_byte(wc * 32 + fr, fq * 8);
#define PG8_SA(b, h) (((b) * 2 + (h)) * HTB)
#define PG8_SB(b, h) ((4 + (b) * 2 + (h)) * HTB)
#define PG8_STAGE(bufoff, gbase, voff) do { _Pragma("unroll") for (int _i = 0; _i < 2; ++_i) \
        __builtin_amdgcn_global_load_lds((const unsigned*)((const char*)(gbase) + (voff)[_i]), (PG8_LAS unsigned*)(lds + (bufoff) + ldsw + _i * 8192), 16, 0, 0); } while (0)
#define PG8_LDA(dst, b, h) do { _Pragma("unroll") for (int m = 0; m < 4; ++m) _Pragma("unroll") for (int k = 0; k < 2; ++k) dst[m][k] = *(const PG8_LAS bf16x8*)(lds + PG8_SA(b, h) + aoff + m * 2048 + k * 1024); } while (0)
#define PG8_LDB(dst, b, h) do { _Pragma("unroll") for (int n = 0; n < 2; ++n) _Pragma("unroll") for (int k = 0; k < 2; ++k) dst[n][k] = *(const PG8_LAS bf16x8*)(lds + PG8_SB(b, h) + boff + n * 2048 + k * 1024); } while (0)
#define PG8_MMA(ai, bj, At, Bt) do { __builtin_amdgcn_s_setprio(1); _Pragma("unroll") for (int m = 0; m < 4; ++m) _Pragma("unroll") for (int n = 0; n < 2; ++n) _Pragma("unroll") for (int k = 0; k < 2; ++k) \
        acc[ai][bj][m][n] = __builtin_amdgcn_mfma_f32_16x16x32_bf16(Bt[n][k], At[m][k], acc[ai][bj][m][n], 0, 0, 0); __builtin_amdgcn_s_setprio(0); } while (0)
#define PG8_WAIT_V(n) asm volatile("s_waitcnt vmcnt(" #n ")" ::: "memory")
#define PG8_WAIT_L(n) asm volatile("s_waitcnt lgkmcnt(" #n ")" ::: "memory")
#define PG8_BAR __builtin_amdgcn_s_barrier()
#define PG8_SCHED __builtin_amdgcn_sched_barrier(0)
    Unit cur, nxt; int ui = 0;
    if (!S.next(0, cur)) return;
    f32x4 acc[2][2][4][2];
#pragma unroll
    for (int a = 0; a < 2; ++a)
#pragma unroll
        for (int b = 0; b < 2; ++b)
#pragma unroll
            for (int m = 0; m < 4; ++m)
#pragma unroll
                for (int n = 0; n < 2; ++n) acc[a][b][m][n] = (f32x4){0.f, 0.f, 0.f, 0.f};
    bf16x8 At[4][2], B0[2][2], B1[2][2];
    const char* cA = (const char*)g.A + (size_t)cur.pm * tstep + (size_t)cur.pk * K * 2; const char* cB = (const char*)g.Bt + (size_t)cur.pn * tstep + (size_t)cur.pk * K * 2;
    S.a_ready(cur);
    if constexpr (SP2) {
        PG8_STAGE(PG8_SB(0, 0), cB, voffB); PG8_STAGE(PG8_SB(0, 1), cB + hstep, voffB); PG8_STAGE(PG8_SA(0, 0), cA, voffA); PG8_STAGE(PG8_SA(0, 1), cA + hstep, voffA);
        if (wr == 1) PG8_BAR;
        PG8_WAIT_V(2); PG8_BAR;
        PG8_STAGE(PG8_SB(1, 0), cB + kstep, voffB); PG8_STAGE(PG8_SA(1, 0), cA + kstep, voffA); PG8_STAGE(PG8_SB(1, 1), cB + hstep + kstep, voffB);
        PG8_WAIT_V(6); PG8_BAR;
    } else {
        PG8_STAGE(PG8_SB(0, 0), cB, voffB); PG8_STAGE(PG8_SA(0, 0), cA, voffA); PG8_STAGE(PG8_SB(0, 1), cB + hstep, voffB); PG8_STAGE(PG8_SA(0, 1), cA + hstep, voffA);
        if (wr == 1) PG8_BAR;
        PG8_WAIT_V(4); PG8_BAR;
        PG8_STAGE(PG8_SB(1, 0), cB + kstep, voffB); PG8_STAGE(PG8_SA(1, 0), cA + kstep, voffA); PG8_STAGE(PG8_SB(1, 1), cB + hstep + kstep, voffB);
        PG8_WAIT_V(6); PG8_BAR;
    }
    for (;;) {
        const bool has_next = S.next(ui + 1, nxt);
        const char* nA = has_next ? (const char*)g.A + (size_t)nxt.pm * tstep + (size_t)nxt.pk * K * 2 : cA; const char* nB = has_next ? (const char*)g.Bt + (size_t)nxt.pn * tstep + (size_t)nxt.pk * K * 2 : cB;
        for (int t = 0; t < nt; t += 2) {
            const bool last = (t == nt - 2);
            const char* a1 = cA + (size_t)(t + 1) * kstep;
            const char* a2 = last ? nA : cA + (size_t)(t + 2) * kstep; const char* b2 = last ? nB : cB + (size_t)(t + 2) * kstep;
            const char* a3 = a2 + kstep; const char* b3 = b2 + kstep;
            if (last && has_next) S.a_ready(nxt);
            if constexpr (SP2) {
            PG8_LDB(B0, 0, 0); PG8_LDB(B1, 0, 1); PG8_SCHED; PG8_LDA(At, 0, 0); PG8_STAGE(PG8_SA(1, 1), a1 + hstep, voffA);
            PG8_WAIT_V(8); PG8_WAIT_L(0); PG8_BAR; PG8_MMA(0, 0, At, B0); PG8_MMA(0, 1, At, B1); PG8_BAR; PG8_SCHED;
            PG8_LDA(At, 0, 1); PG8_STAGE(PG8_SB(0, 0), b2, voffB); PG8_STAGE(PG8_SB(0, 1), b2 + hstep, voffB); PG8_STAGE(PG8_SA(0, 0), a2, voffA);
            PG8_WAIT_V(8); PG8_WAIT_L(0); PG8_BAR; PG8_MMA(1, 0, At, B0); PG8_MMA(1, 1, At, B1); PG8_BAR; PG8_SCHED;
            PG8_LDB(B0, 1, 0); PG8_LDB(B1, 1, 1); PG8_SCHED; PG8_LDA(At, 1, 0); PG8_STAGE(PG8_SA(0, 1), a2 + hstep, voffA);
            PG8_WAIT_V(8); PG8_WAIT_L(0); PG8_BAR; PG8_MMA(0, 0, At, B0); PG8_MMA(0, 1, At, B1); PG8_BAR; PG8_SCHED;
            PG8_LDA(At, 1, 1); PG8_STAGE(PG8_SB(1, 0), b3, voffB); PG8_STAGE(PG8_SB(1, 1), b3 + hstep, voffB); PG8_STAGE(PG8_SA(1, 0), a3, voffA);
            PG8_WAIT_V(8); PG8_WAIT_L(0); PG8_BAR; PG8_MMA(1, 0, At, B0); PG8_MMA(1, 1, At, B1); PG8_BAR; PG8_SCHED;
            } else {
            PG8_LDB(B0, 0, 0); PG8_SCHED; PG8_LDA(At, 0, 0); PG8_STAGE(PG8_SA(1, 1), a1 + hstep, voffA);
            PG8_WAIT_L(8); PG8_BAR; PG8_WAIT_L(0); PG8_MMA(0, 0, At, B0); PG8_BAR; PG8_SCHED;
            PG8_LDB(B1, 0, 1); PG8_STAGE(PG8_SB(0, 0), b2, voffB);
            PG8_BAR; PG8_WAIT_L(0); PG8_MMA(0, 1, At, B1); PG8_BAR;
            PG8_LDA(At, 0, 1); PG8_STAGE(PG8_SA(0, 0), a2, voffA);
            PG8_BAR; PG8_WAIT_L(0); PG8_MMA(1, 0, At, B0); PG8_BAR; PG8_SCHED;
            PG8_STAGE(PG8_SB(0, 1), b2 + hstep, voffB);
            PG8_WAIT_V(6); PG8_BAR; PG8_MMA(1, 1, At, B1); PG8_BAR;
            PG8_LDB(B0, 1, 0); PG8_SCHED; PG8_LDA(At, 1, 0); PG8_STAGE(PG8_SA(0, 1), a2 + hstep, voffA);
            PG8_WAIT_L(8); PG8_BAR; PG8_WAIT_L(0); PG8_MMA(0, 0, At, B0); PG8_BAR; PG8_SCHED;
            PG8_LDB(B1, 1, 1); PG8_STAGE(PG8_SB(1, 0), b3, voffB);
            PG8_BAR; PG8_WAIT_L(0); PG8_MMA(0, 1, At, B1); PG8_BAR;
            PG8_LDA(At, 1, 1); PG8_STAGE(PG8_SA(1, 0), a3, voffA);
            PG8_BAR; PG8_WAIT_L(0); PG8_MMA(1, 0, At, B0); PG8_BAR; PG8_SCHED;
            PG8_STAGE(PG8_SB(1, 1), b3 + hstep, voffB);
            PG8_WAIT_V(6); PG8_BAR; PG8_MMA(1, 1, At, B1); PG8_BAR;
            }
        }
        if constexpr (ALIGN_EPI) { if (wr == 0) PG8_BAR; }
        if constexpr (!Epi::AFTER_DRAIN) { E(acc, cur, wr, wc, fr, fq); S.done(cur); }
        if (!has_next) break;
#pragma unroll
        for (int a = 0; a < 2; ++a)
#pragma unroll
            for (int b = 0; b < 2; ++b)
#pragma unroll
                for (int m = 0; m < 4; ++m)
#pragma unroll
                    for (int n = 0; n < 2; ++n) acc[a][b][m][n] = (f32x4){0.f, 0.f, 0.f, 0.f};
        cur = nxt; cA = nA; cB = nB; ++ui;
        if constexpr (ALIGN_EPI) { if (wr == 1) PG8_BAR; }
    }
    PG8_WAIT_V(0);
    if constexpr (!ALIGN_EPI) { if (wr == 0) PG8_BAR; }
    PG8_BAR;
    if constexpr (Epi::AFTER_DRAIN) { E.fused(acc, cur, wr, wc, fr, fq, lds, wid, lane); S.done(cur); }
#undef PG8_SA
#undef PG8_SB
#undef PG8_STAGE
#undef PG8_LDA
#undef PG8_LDB
#undef PG8_MMA
#undef PG8_WAIT_V
#undef PG8_WAIT_L
#undef PG8_BAR
#undef PG8_SCHED
}
}

#define DI __device__ __forceinline__
#define LAS __attribute__((address_space(3)))
typedef unsigned short bf16_t;
typedef short bf16x8 __attribute__((ext_vector_type(8)));
typedef short s16x4 __attribute__((ext_vector_type(4)));
typedef float f32x4 __attribute__((ext_vector_type(4)));
typedef float f32x2 __attribute__((ext_vector_type(2)));
typedef float f32x16 __attribute__((ext_vector_type(16)));
typedef unsigned u32x4 __attribute__((ext_vector_type(4)));
typedef unsigned u32x2 __attribute__((ext_vector_type(2)));
using pg8::cvt_pk_bf16;

constexpr int DM = 1024, NB = 4, SEQ = 4096, CTXL = 256;
constexpr int ML = NB * SEQ;
constexpr int MC = NB * CTXL;
constexpr int MT = ML + MC;
constexpr int DFF = 2816, DIN = 2048, NXBC = 4096, NXBCP = 4352, VTP = 4352;
constexpr float EPS = 1e-6f;
constexpr float LOG2E = 1.4426950408889634f;
constexpr float QSCALE = 0.125f * LOG2E;

constexpr size_t MiB = 1u << 20;
constexpr size_t WS_MOD = 0;
constexpr size_t WS_SSQ = 256 * 1024;
constexpr size_t WS_BAR = 800 * 1024;
constexpr size_t WS_ROPE = 900 * 1024;
constexpr size_t CTL_BYTES = 1 * MiB;
constexpr size_t WS_CTXR = 1 * MiB;
constexpr size_t WS_HN = 5 * MiB;
constexpr size_t WS_DT = 39 * MiB;
constexpr size_t WS_WZ = 44 * MiB;
constexpr size_t WS_WOUT = 48 * MiB;
constexpr size_t WS_Q = 56 * MiB;
constexpr size_t WS_K = 90 * MiB;
constexpr size_t WS_VT = 99 * MiB;
constexpr size_t WS_HB0 = 56 * MiB;
constexpr size_t WS_XBC = 56 * MiB;
constexpr size_t WS_GU1 = 56 * MiB;
constexpr size_t WS_DN1 = 67 * MiB;
constexpr size_t WS_HB1 = 73 * MiB;
constexpr size_t WS_WXBC = 192 * MiB;
constexpr size_t WS_WQKV = 201 * MiB;
constexpr size_t WS_WO = 204 * MiB;
constexpr size_t WS_GU0 = 206 * MiB;
constexpr size_t WS_DN0 = 217 * MiB;
constexpr size_t WS_Y = 192 * MiB;
constexpr size_t WS_PARTA = 150 * MiB;
constexpr size_t WS_PARTB = 223 * MiB;
constexpr size_t WS_HALO = 202 * MiB;
constexpr size_t WS_END = 256 * MiB;

constexpr int LDS_BYTES = 160000;

DI float bflo(unsigned u) { return __uint_as_float(u << 16); }
DI float bfhi(unsigned u) { return __uint_as_float(u & 0xffff0000u); }
DI float silu_f(float x) { return x * __builtin_amdgcn_rcpf(1.0f + __expf(-x)); }
DI float wave_sum(float v) {
#pragma unroll
    for (int o = 1; o < 64; o <<= 1) v += __shfl_xor(v, o);
    return v;
}
#define LDS_WAIT() asm volatile("s_waitcnt lgkmcnt(0)" ::: "memory")

struct EpiQKV {
    static constexpr bool PERM = false, AFTER_DRAIN = false;
    bf16_t* Q; bf16_t* K; bf16_t* VT; const float* rope;
    DI void operator()(const f32x4 (&acc)[2][2][4][2], const pg8::Unit& u, int wr, int wc, int fr, int fq) const {
        const int pn = u.pn; const bool isctx = u.pm >= 64;
#pragma unroll
        for (int ai = 0; ai < 2; ++ai)
#pragma unroll
            for (int m = 0; m < 4; ++m) {
                const int row = u.pm * 256 + ai * 128 + wr * 64 + m * 16 + fr;
                int b, t; if (!isctx) { b = row >> 12; t = row & 4095; } else { const int rc = row - ML; b = rc >> 8; t = rc & 255; }
#pragma unroll
                for (int bj = 0; bj < 2; ++bj) {
                    f32x4 v0 = acc[ai][bj][m][0], v1 = acc[ai][bj][m][1];
                    const int colt = bj * 128 + wc * 32;
                    if (pn < 5 && !isctx) {
                        const int pos = (wc & 1) ? (t & 63) : (t >> 6);
                        const f32x4 c4 = *(const f32x4*)(rope + pos * 16 + 4 * fq), s4 = *(const f32x4*)(rope + 1024 + pos * 16 + 4 * fq);
                        const f32x4 r0 = v0 * c4 - v1 * s4, r1 = v1 * c4 + v0 * s4; v0 = r0; v1 = r1;
                    }
                    if (pn < 4) {
                        v0 = v0 * QSCALE; v1 = v1 * QSCALE;
                        bf16_t* p = Q + (size_t)row * 1024 + pn * 256 + colt + 4 * fq;
                        u32x2 a; a.x = cvt_pk_bf16(v0[0], v0[1]); a.y = cvt_pk_bf16(v0[2], v0[3]); *(u32x2*)p = a;
                        u32x2 c; c.x = cvt_pk_bf16(v1[0], v1[1]); c.y = cvt_pk_bf16(v1[2], v1[3]); *(u32x2*)(p + 16) = c;
                    } else if (pn == 4) {
                        bf16_t* p = K + (size_t)row * 256 + colt + 4 * fq;
                        u32x2 a; a.x = cvt_pk_bf16(v0[0], v0[1]); a.y = cvt_pk_bf16(v0[2], v0[3]); *(u32x2*)p = a;
                        u32x2 c; c.x = cvt_pk_bf16(v1[0], v1[1]); c.y = cvt_pk_bf16(v1[2], v1[3]); *(u32x2*)(p + 16) = c;
                    } else {
                        const int g = bj * 2 + (wc >> 1); const int d0 = (wc & 1) * 32 + 4 * fq; const int pos = isctx ? 4096 + t : t;
                        bf16_t* p = VT + ((size_t)((b * 4 + g) * 64 + d0)) * VTP + pos;
#pragma unroll
                        for (int e = 0; e < 4; ++e) {
                            p[(size_t)e * VTP] = (bf16_t)(cvt_pk_bf16(v0[e], 0.f) & 0xffffu);
                            p[(size_t)(16 + e) * VTP] = (bf16_t)(cvt_pk_bf16(v1[e], 0.f) & 0xffffu);
                        }
                    }
                }
            }
    }
};

struct EpiRes {
    static constexpr bool PERM = false, AFTER_DRAIN = false;
    const float* baseL; const float* baseC; float* outL; float* outC; const float* gate;
    DI void operator()(const f32x4 (&acc)[2][2][4][2], const pg8::Unit& u, int wr, int wc, int fr, int fq) const {
        const bool isctx = u.pm >= 64; const int mrow = isctx ? 4 : (u.pm >> 4);
        const float* base = isctx ? baseC - (size_t)ML * 1024 : baseL; float* out = isctx ? outC - (size_t)ML * 1024 : outL;
#pragma unroll
        for (int bj = 0; bj < 2; ++bj)
#pragma unroll
            for (int n = 0; n < 2; ++n) {
                const int col = u.pn * 256 + bj * 128 + wc * 32 + 16 * n + 4 * fq;
                const f32x4 g4 = *(const f32x4*)(gate + mrow * 6144 + col);
#pragma unroll
                for (int ai = 0; ai < 2; ++ai)
#pragma unroll
                    for (int m = 0; m < 4; ++m) {
                        const size_t off = (size_t)(u.pm * 256 + ai * 128 + wr * 64 + m * 16 + fr) * 1024 + col;
                        const f32x4 bs = *(const f32x4*)(base + off);
                        *(f32x4*)(out + off) = bs + g4 * acc[ai][bj][m][n];
                    }
            }
    }
};

struct EpiPart {
    static constexpr bool PERM = false, AFTER_DRAIN = false;
    float* pA; float* pB;
    DI void operator()(const f32x4 (&acc)[2][2][4][2], const pg8::Unit& u, int wr, int wc, int fr, int fq) const {
        float* out = (u.pk < 10 ? pA + (size_t)u.pk * MC * 1024 : pB) - (size_t)ML * 1024;
#pragma unroll
        for (int bj = 0; bj < 2; ++bj)
#pragma unroll
            for (int n = 0; n < 2; ++n) {
                const int col = u.pn * 256 + bj * 128 + wc * 32 + 16 * n + 4 * fq;
#pragma unroll
                for (int ai = 0; ai < 2; ++ai)
#pragma unroll
                    for (int m = 0; m < 4; ++m) *(f32x4*)(out + (size_t)(u.pm * 256 + ai * 128 + wr * 64 + m * 16 + fr) * 1024 + col) = acc[ai][bj][m][n];
            }
    }
};

struct EpiSwi {
    static constexpr bool PERM = true, AFTER_DRAIN = false;
    bf16_t* H;
    DI void operator()(const f32x4 (&acc)[2][2][4][2], const pg8::Unit& u, int wr, int wc, int fr, int fq) const {
        const int col = u.pn * 128 + wc * 32 + 8 * fq;
#pragma unroll
        for (int ai = 0; ai < 2; ++ai)
#pragma unroll
            for (int m = 0; m < 4; ++m) {
                const int row = u.pm * 256 + ai * 128 + wr * 64 + m * 16 + fr;
                const f32x4 g0 = acc[ai][0][m][0], g1 = acc[ai][0][m][1], u0 = acc[ai][1][m][0], u1 = acc[ai][1][m][1];
                u32x4 w;
                w.x = cvt_pk_bf16(silu_f(g0[0]) * u0[0], silu_f(g0[1]) * u0[1]); w.y = cvt_pk_bf16(silu_f(g0[2]) * u0[2], silu_f(g0[3]) * u0[3]);
                w.z = cvt_pk_bf16(silu_f(g1[0]) * u1[0], silu_f(g1[1]) * u1[1]); w.w = cvt_pk_bf16(silu_f(g1[2]) * u1[2], silu_f(g1[3]) * u1[3]);
                *(u32x4*)(H + (size_t)row * DFF + col) = w;
            }
    }
};

struct EpiXbc {
    static constexpr bool PERM = true, AFTER_DRAIN = false;
    bf16_t* X; float* DT; const float* dtb; bf16_t* HALO;
    DI void operator()(const f32x4 (&acc)[2][2][4][2], const pg8::Unit& u, int wr, int wc, int fr, int fq) const {
        if (u.pn < 16) {
#pragma unroll
            for (int ai = 0; ai < 2; ++ai)
#pragma unroll
                for (int m = 0; m < 4; ++m) {
                    const int row = u.pm * 256 + ai * 128 + wr * 64 + m * 16 + fr;
#pragma unroll
                    for (int bj = 0; bj < 2; ++bj) {
                        const f32x4 v0 = acc[ai][bj][m][0], v1 = acc[ai][bj][m][1];
                        u32x4 w; w.x = cvt_pk_bf16(v0[0], v0[1]); w.y = cvt_pk_bf16(v0[2], v0[3]); w.z = cvt_pk_bf16(v1[0], v1[1]); w.w = cvt_pk_bf16(v1[2], v1[3]);
                        *(u32x4*)(X + (size_t)row * NXBC + u.pn * 256 + bj * 128 + wc * 32 + 8 * fq) = w;
                        if (fr == 0 || fr == 15) *(u32x4*)(HALO + ((size_t)(row >> 4) * 2 + (fr == 15 ? 1 : 0)) * NXBC + u.pn * 256 + bj * 128 + wc * 32 + 8 * fq) = w;
                    }
                }
        } else if (wc < 2) {
#pragma unroll
            for (int n = 0; n < 2; ++n) {
                const int ct = wc * 32 + 8 * fq + 4 * n;
                const f32x4 b4 = *(const f32x4*)(dtb + ct);
#pragma unroll
                for (int ai = 0; ai < 2; ++ai)
#pragma unroll
                    for (int m = 0; m < 4; ++m) {
                        const int row = u.pm * 256 + ai * 128 + wr * 64 + m * 16 + fr;
                        const f32x4 v = acc[ai][0][m][n] + b4; f32x4 o;
#pragma unroll
                        for (int e = 0; e < 4; ++e) o[e] = v[e] > 20.f ? v[e] : log1pf(__expf(v[e]));
                        *(f32x4*)(DT + (size_t)row * 64 + ct) = o;
                    }
            }
        }
    }
};

struct EpiZ {
    static constexpr bool PERM = true, AFTER_DRAIN = false;
    bf16_t* Y; const float* ng; LAS float* P4;
    DI void operator()(f32x4 (&acc)[2][2][4][2], const pg8::Unit& u, int wr, int wc, int fr, int fq) const {
#pragma unroll
        for (int ai = 0; ai < 2; ++ai)
#pragma unroll
            for (int m = 0; m < 4; ++m) {
                const int rl = ai * 128 + wr * 64 + m * 16 + fr; const int row = u.pm * 256 + rl; float ss = 0.f;
#pragma unroll
                for (int bj = 0; bj < 2; ++bj) {
                    const bf16_t* p = Y + (size_t)row * DIN + u.pn * 256 + bj * 128 + wc * 32 + 8 * fq;
                    const u32x4 yv = *(const u32x4*)p; const f32x4 z0 = acc[ai][bj][m][0], z1 = acc[ai][bj][m][1];
                    f32x4 o0, o1;
                    o0[0] = bflo(yv.x) * silu_f(z0[0]); o0[1] = bfhi(yv.x) * silu_f(z0[1]); o0[2] = bflo(yv.y) * silu_f(z0[2]); o0[3] = bfhi(yv.y) * silu_f(z0[3]);
                    o1[0] = bflo(yv.z) * silu_f(z1[0]); o1[1] = bfhi(yv.z) * silu_f(z1[1]); o1[2] = bflo(yv.w) * silu_f(z1[2]); o1[3] = bfhi(yv.w) * silu_f(z1[3]);
                    ss += (o0[0] * o0[0] + o0[1] * o0[1]) + (o0[2] * o0[2] + o0[3] * o0[3]) + (o1[0] * o1[0] + o1[1] * o1[1]) + (o1[2] * o1[2] + o1[3] * o1[3]);
                    acc[ai][bj][m][0] = o0; acc[ai][bj][m][1] = o1;
                }
                ss += __shfl_xor(ss, 16); ss += __shfl_xor(ss, 32);
                if (fq == 0) P4[rl * 4 + wc] = ss;
            }
        asm volatile("s_waitcnt lgkmcnt(0)" ::: "memory"); __builtin_amdgcn_s_barrier(); asm volatile("" ::: "memory");
        f32x4 g[2][2];
#pragma unroll
        for (int bj = 0; bj < 2; ++bj) { g[bj][0] = *(const f32x4*)(ng + u.pn * 256 + bj * 128 + wc * 32 + 8 * fq); g[bj][1] = *(const f32x4*)(ng + u.pn * 256 + bj * 128 + wc * 32 + 8 * fq + 4); }
#pragma unroll
        for (int ai = 0; ai < 2; ++ai)
#pragma unroll
            for (int m = 0; m < 4; ++m) {
                const int rl = ai * 128 + wr * 64 + m * 16 + fr; const int row = u.pm * 256 + rl;
                const f32x4 ps = *(const LAS f32x4*)(P4 + rl * 4);
                const float rstd = 1.0f / sqrtf(((ps[0] + ps[1]) + (ps[2] + ps[3])) * (1.0f / 256.0f) + EPS);
#pragma unroll
                for (int bj = 0; bj < 2; ++bj) {
                    const f32x4 o0 = acc[ai][bj][m][0] * rstd * g[bj][0], o1 = acc[ai][bj][m][1] * rstd * g[bj][1];
                    u32x4 w; w.x = cvt_pk_bf16(o0[0], o0[1]); w.y = cvt_pk_bf16(o0[2], o0[3]); w.z = cvt_pk_bf16(o1[0], o1[1]); w.w = cvt_pk_bf16(o1[2], o1[3]);
                    *(u32x4*)(Y + (size_t)row * DIN + u.pn * 256 + bj * 128 + wc * 32 + 8 * fq) = w;
                }
            }
        asm volatile("s_waitcnt lgkmcnt(0)" ::: "memory"); __builtin_amdgcn_s_barrier(); asm volatile("" ::: "memory");
    }
};

DI void transpose_item(const float* W, int N, bf16_t* WT, int K, int k0, int n0, int drow0, LAS float* scr, int lane) {
#pragma unroll
    for (int i = 0; i < 32; ++i) { const int kk = 2 * i + (lane >> 5); scr[kk * 33 + (lane & 31)] = W[(size_t)(k0 + kk) * N + n0 + (lane & 31)]; }
    LDS_WAIT(); asm volatile("" ::: "memory");
    const int c = lane & 7;
#pragma unroll
    for (int j = 0; j < 4; ++j) { const int n = (lane >> 3) + 8 * j; const LAS float* s = scr + (8 * c) * 33 + n;
        u32x4 o; o.x = cvt_pk_bf16(s[0 * 33], s[1 * 33]); o.y = cvt_pk_bf16(s[2 * 33], s[3 * 33]); o.z = cvt_pk_bf16(s[4 * 33], s[5 * 33]); o.w = cvt_pk_bf16(s[6 * 33], s[7 * 33]);
        *(u32x4*)(WT + (size_t)(drow0 + n) * K + k0 + 8 * c) = o; }
    LDS_WAIT(); asm volatile("" ::: "memory");
}
DI void conv_job(const float* W, int K, int N, bf16_t* T, bf16_t* T2, int mode, int item, LAS float* scr, int lane) {
    const int nblk = N / 32, kb = item / nblk, nb = item - kb * nblk, k0 = 64 * kb, n0 = 32 * nb;
    int drow0 = n0; bf16_t* dst = T;
    if (mode == 1) drow0 = (n0 >> 7) * 256 + (n0 & 127);
    else if (mode == 2) drow0 = (n0 >> 7) * 256 + 128 + (n0 & 127);
    else if (mode == 3) { if (n0 >= 2048) { dst = T2; drow0 = n0 - 2048; } }
    transpose_item(W, N, dst, K, k0, n0, drow0, scr, lane);
}

struct Params { const float* in[23]; float* out; unsigned char* ws; int ph_lo, ph_hi; };

DI void phase0(const Params& P, LAS unsigned char* lds, int vcu, int G) {
    const int tid = threadIdx.x, lane = tid & 63, wave = __builtin_amdgcn_readfirstlane(tid >> 6);
    unsigned char* ws = P.ws;
    LAS float* S = (LAS float*)(lds + 70000);
    for (int i = tid; i < 5 * 1024; i += 512) { const int m = i >> 10, k = i & 1023; const float v = m < 4 ? P.in[1][m * 1024 + k] : P.in[3][k]; S[i] = silu_f(v); }
    __syncthreads();
    float* MOD = (float*)(ws + WS_MOD);
    LAS float* RED = (LAS float*)(lds + 96000);
    for (int it = blockIdx.x; it < 192; it += G) {
        const int l = it / 96, n = (it - l * 96) * 64 + (tid & 63), ksl = tid >> 6;
        const float* w = P.in[4] + (size_t)l * 1024 * 6144 + (size_t)(ksl * 128) * 6144 + n;
        float a0 = 0.f, a1 = 0.f, a2 = 0.f, a3 = 0.f, a4 = 0.f;
#pragma unroll 16
        for (int k = 0; k < 128; ++k) { const float wv = w[(size_t)k * 6144]; const int kk = ksl * 128 + k;
            a0 += S[kk] * wv; a1 += S[1024 + kk] * wv; a2 += S[2048 + kk] * wv; a3 += S[3072 + kk] * wv; a4 += S[4096 + kk] * wv; }
        __syncthreads();
        RED[(ksl * 5 + 0) * 64 + (tid & 63)] = a0; RED[(ksl * 5 + 1) * 64 + (tid & 63)] = a1; RED[(ksl * 5 + 2) * 64 + (tid & 63)] = a2; RED[(ksl * 5 + 3) * 64 + (tid & 63)] = a3; RED[(ksl * 5 + 4) * 64 + (tid & 63)] = a4;
        __syncthreads();
        if (tid < 320) { const int m = tid >> 6, c = tid & 63; float sum = P.in[5][l * 6144 + (it - l * 96) * 64 + c];
#pragma unroll
            for (int q = 0; q < 8; ++q) sum += RED[(q * 5 + m) * 64 + c];
            MOD[(size_t)l * 5 * 6144 + m * 6144 + (it - l * 96) * 64 + c] = sum; }
    }
    if (blockIdx.x == 0) {
        float* rope = (float*)(ws + WS_ROPE);
        for (int i = tid; i < 1024; i += 512) { const int pos = i >> 4, f = i & 15; const float inv = powf(10000.0f, -(float)f / 16.0f); const float ang = (float)pos * inv;
            rope[i] = cosf(ang); rope[1024 + i] = sinf(ang); }
    }
    { bf16_t* wx = (bf16_t*)(ws + WS_WXBC); const int total = (NXBCP - 4160) * 1024 / 8;
      for (int i = blockIdx.x * 512 + tid; i < total; i += G * 512) *(u32x4*)(wx + (size_t)4160 * 1024 + (size_t)i * 8) = (u32x4){0u, 0u, 0u, 0u}; }
    LAS float* scr = (LAS float*)(lds + wave * 8448);
    const int gw = vcu * 8 + wave, NGW = G * 8;
    constexpr int I_QKV = 16 * 48, I_WO = 16 * 32, I_G = 16 * 88, I_D = 44 * 32, I_IN = 16 * 194, I_OUT = 32 * 32;
    constexpr int NIT = I_QKV + I_WO + 2 * I_G + I_D + I_IN + I_OUT;
    for (int it = gw; it < NIT; it += NGW) {
        int r = it;
        if (r < I_QKV) { conv_job(P.in[8], 1024, 1536, (bf16_t*)(ws + WS_WQKV), nullptr, 0, r, scr, lane); continue; } r -= I_QKV;
        if (r < I_WO) { conv_job(P.in[9], 1024, 1024, (bf16_t*)(ws + WS_WO), nullptr, 0, r, scr, lane); continue; } r -= I_WO;
        if (r < I_G) { conv_job(P.in[19], 1024, DFF, (bf16_t*)(ws + WS_GU0), nullptr, 1, r, scr, lane); continue; } r -= I_G;
        if (r < I_G) { conv_job(P.in[20], 1024, DFF, (bf16_t*)(ws + WS_GU0), nullptr, 2, r, scr, lane); continue; } r -= I_G;
        if (r < I_D) { conv_job(P.in[21], DFF, 1024, (bf16_t*)(ws + WS_DN0), nullptr, 0, r, scr, lane); continue; } r -= I_D;
        if (r < I_IN) { conv_job(P.in[11], 1024, 6208, (bf16_t*)(ws + WS_WZ), (bf16_t*)(ws + WS_WXBC), 3, r, scr, lane); continue; } r -= I_IN;
        conv_job(P.in[18], DIN, 1024, (bf16_t*)(ws + WS_WOUT), nullptr, 0, r, scr, lane);
    }
}

DI void phase_conv_ffn1(const Params& P, LAS unsigned char* lds, int vcu, int G) {
    const int tid = threadIdx.x, lane = tid & 63, wave = __builtin_amdgcn_readfirstlane(tid >> 6);
    unsigned char* ws = P.ws;
    LAS float* scr = (LAS float*)(lds + wave * 8448);
    const int gw = vcu * 8 + wave, NGW = G * 8;
    constexpr int I_G = 16 * 88, I_D = 44 * 32, NIT = 2 * I_G + I_D;
    const size_t o1 = (size_t)1024 * DFF;
    for (int it = gw; it < NIT; it += NGW) {
        int r = it;
        if (r < I_G) { conv_job(P.in[19] + o1, 1024, DFF, (bf16_t*)(ws + WS_GU1), nullptr, 1, r, scr, lane); continue; } r -= I_G;
        if (r < I_G) { conv_job(P.in[20] + o1, 1024, DFF, (bf16_t*)(ws + WS_GU1), nullptr, 2, r, scr, lane); continue; } r -= I_G;
        conv_job(P.in[21] + o1, DFF, 1024, (bf16_t*)(ws + WS_DN1), nullptr, 0, r, scr, lane);
    }
}

struct CtxPart { const float* pA; const float* pB; const float* gate; float* ctx_out; int ns; };
DI void norm_phase(const float* xL, const float* xC, const float* g, const float* mod, int shoff, int scoff, bf16_t* HN, int nrows, int gw, int NGW, int lane, const CtxPart cp) {
    for (int row = gw; row < nrows; row += NGW) {
        const float* src = row < ML ? xL + (size_t)row * 1024 : xC + (size_t)(row - ML) * 1024; const int m = row < ML ? (row >> 12) : 4;
        f32x4 v[4]; float ss = 0.f;
#pragma unroll
        for (int j = 0; j < 4; ++j) v[j] = *(const f32x4*)(src + 4 * lane + 256 * j);
        if (row >= ML && cp.ns > 0) {
            const size_t ro = (size_t)(row - ML) * 1024;
#pragma unroll
            for (int j = 0; j < 4; ++j) { const int col = 4 * lane + 256 * j; f32x4 acc4 = (f32x4){0.f, 0.f, 0.f, 0.f};
                for (int k = 0; k < cp.ns; ++k) { const float* pp = (k < 10 ? cp.pA + (size_t)k * MC * 1024 : cp.pB) + ro + col; acc4 += *(const f32x4*)pp; }
                v[j] += *(const f32x4*)(cp.gate + col) * acc4; *(f32x4*)(cp.ctx_out + ro + col) = v[j]; }
        }
#pragma unroll
        for (int j = 0; j < 4; ++j) ss += (v[j].x * v[j].x + v[j].y * v[j].y) + (v[j].z * v[j].z + v[j].w * v[j].w);
        const float rstd = 1.0f / sqrtf(wave_sum(ss) * (1.0f / 1024.0f) + EPS);
#pragma unroll
        for (int j = 0; j < 4; ++j) { const int col = 4 * lane + 256 * j;
            const f32x4 g4 = *(const f32x4*)(g + col), sc = *(const f32x4*)(mod + m * 6144 + scoff + col), sh = *(const f32x4*)(mod + m * 6144 + shoff + col);
            const f32x4 o = (v[j] * rstd * g4) * (sc + 1.0f) + sh;
            u32x2 w; w.x = cvt_pk_bf16(o[0], o[1]); w.y = cvt_pk_bf16(o[2], o[3]); *(u32x2*)(HN + (size_t)row * 1024 + col) = w; }
    }
}
DI void final_norm_phase(float* x, const float* g, int gw, int NGW, int lane) {
    for (int row0 = gw; row0 < ML; row0 += 2 * NGW) {
        const int row1 = row0 + NGW; const bool has1 = row1 < ML; const int r1 = has1 ? row1 : row0;
        float* s0 = x + (size_t)row0 * 1024; float* s1 = x + (size_t)r1 * 1024; f32x4 v0[4], v1[4]; float ss0 = 0.f, ss1 = 0.f;
#pragma unroll
        for (int j = 0; j < 4; ++j) { v0[j] = *(const f32x4*)(s0 + 4 * lane + 256 * j); v1[j] = *(const f32x4*)(s1 + 4 * lane + 256 * j); }
#pragma unroll
        for (int j = 0; j < 4; ++j) { ss0 += (v0[j].x * v0[j].x + v0[j].y * v0[j].y) + (v0[j].z * v0[j].z + v0[j].w * v0[j].w); ss1 += (v1[j].x * v1[j].x + v1[j].y * v1[j].y) + (v1[j].z * v1[j].z + v1[j].w * v1[j].w); }
#pragma unroll
        for (int o = 1; o < 64; o <<= 1) { ss0 += __shfl_xor(ss0, o); ss1 += __shfl_xor(ss1, o); }
        const float rstd0 = 1.0f / sqrtf(ss0 * (1.0f / 1024.0f) + EPS), rstd1 = 1.0f / sqrtf(ss1 * (1.0f / 1024.0f) + EPS);
#pragma unroll
        for (int j = 0; j < 4; ++j) { const int col = 4 * lane + 256 * j; const f32x4 g4 = *(const f32x4*)(g + col);
            *(f32x4*)(s0 + col) = v0[j] * rstd0 * g4; if (has1) *(f32x4*)(s1 + col) = v1[j] * rstd1 * g4; }
    }
}
DI void gnorm_phase(bf16_t* Y, const float* SSQ, const float* ng, int G) {
    const int total = ML * 256;
    for (int i = blockIdx.x * 512 + threadIdx.x; i < total; i += G * 512) {
        const int row = i >> 8, col = (i & 255) * 8; const float rstd = 1.0f / sqrtf(SSQ[(size_t)row * 8 + (col >> 8)] * (1.0f / 256.0f) + EPS);
        bf16_t* p = Y + (size_t)row * DIN + col; const u32x4 v = *(const u32x4*)p; const f32x4 g0 = *(const f32x4*)(ng + col), g1 = *(const f32x4*)(ng + col + 4);
        u32x4 w; w.x = cvt_pk_bf16(bflo(v.x) * rstd * g0[0], bfhi(v.x) * rstd * g0[1]); w.y = cvt_pk_bf16(bflo(v.y) * rstd * g0[2], bfhi(v.y) * rstd * g0[3]);
        w.z = cvt_pk_bf16(bflo(v.z) * rstd * g1[0], bfhi(v.z) * rstd * g1[1]); w.w = cvt_pk_bf16(bflo(v.w) * rstd * g1[2], bfhi(v.w) * rstd * g1[3]);
        *(u32x4*)p = w;
    }
}

#define MFMA32(a, b, c) __builtin_amdgcn_mfma_f32_32x32x16_bf16((a), (b), (c), 0, 0, 0)
#define MFMA16(a, b, c) __builtin_amdgcn_mfma_f32_16x16x32_bf16((a), (b), (c), 0, 0, 0)
DI int crow(int r, int hi) { return (r & 3) + 8 * (r >> 2) + 4 * hi; }
DI bf16x8 pack8(float a0, float a1, float a2, float a3, float a4, float a5, float a6, float a7) {
    u32x4 p; p.x = cvt_pk_bf16(a0, a1); p.y = cvt_pk_bf16(a2, a3); p.z = cvt_pk_bf16(a4, a5); p.w = cvt_pk_bf16(a6, a7); return __builtin_bit_cast(bf16x8, p);
}
DI void attn_phase(LAS unsigned char* lds, const bf16_t* Q, bf16_t* O, const bf16_t* Kb, const bf16_t* VT, const float* sinks, int vcu, int G) {
    const int tid = threadIdx.x, lane = tid & 63, w = __builtin_amdgcn_readfirstlane(tid >> 6), r = lane & 31, h = lane >> 5;
    constexpr int KST = 144, VST = 1168, KBYTES = 576 * KST;
    LAS unsigned char* Ks = lds; LAS unsigned char* Vs = lds + KBYTES;
    for (int u = vcu; u < 1088; u += G) {
        int b, g, q0, nk; bool isctx;
        if (u < 1024) { b = u >> 8; g = (u >> 6) & 3; q0 = (u & 63) * 64; nk = 576; isctx = false; }
        else { const int uc = u - 1024; b = uc >> 4; g = (uc >> 2) & 3; q0 = (uc & 3) * 64; nk = 256; isctx = true; }
#pragma unroll 3
        for (int c = tid; c < nk * 8; c += 512) {
            const int s = c >> 3, part = c & 7; size_t grow; bool ok = true;
            if (s < 256) grow = (size_t)ML + b * 256 + s; else { const int pos = q0 - 128 + (s - 256); ok = pos >= 0 && pos < SEQ; grow = (size_t)b * SEQ + pos; }
            u32x4 v = (u32x4){0u, 0u, 0u, 0u}; if (ok) v = *(const u32x4*)(Kb + grow * 256 + g * 64 + part * 8);
            *(LAS u32x4*)(Ks + s * KST + part * 16) = v;
        }
        const int cpr = nk >> 3;
#pragma unroll 3
        for (int c = tid; c < 64 * cpr; c += 512) {
            const int d = c / cpr, s = (c - d * cpr) * 8; int pos; bool ok = true;
            if (s < 256) pos = 4096 + s; else { pos = q0 - 128 + (s - 256); ok = pos >= 0 && pos < SEQ; }
            u32x4 v = (u32x4){0u, 0u, 0u, 0u}; if (ok) v = *(const u32x4*)(VT + (size_t)((b * 4 + g) * 64 + d) * VTP + pos);
            *(LAS u32x4*)(Vs + d * VST + s * 2) = v;
        }
        const int hq = g * 4 + (w >> 1), ql = 32 * (w & 1) + r;
        const size_t qrow = (isctx ? (size_t)ML + b * 256 : (size_t)b * SEQ) + q0 + ql;
        bf16x8 qf[4];
#pragma unroll
        for (int d0 = 0; d0 < 4; ++d0) qf[d0] = *(const bf16x8*)(Q + qrow * 1024 + hq * 64 + d0 * 16 + h * 8);
        __syncthreads();
        float m_run = sinks[hq] * LOG2E, l_run = (h == 0) ? 1.f : 0.f;
        f32x16 o0, o1;
#pragma unroll
        for (int i = 0; i < 16; ++i) { o0[i] = 0.f; o1[i] = 0.f; }
        const int qpos = q0 + ql, ntile = nk >> 6;
        for (int kt = 0; kt < ntile; ++kt) {
            f32x16 p0, p1;
#pragma unroll
            for (int i = 0; i < 16; ++i) { p0[i] = 0.f; p1[i] = 0.f; }
            const LAS unsigned char* kb = Ks + (kt * 64 + r) * KST + h * 16;
#pragma unroll
            for (int d0 = 0; d0 < 4; ++d0) {
                const bf16x8 a0 = *(const LAS bf16x8*)(kb + d0 * 32), a1 = *(const LAS bf16x8*)(kb + 32 * KST + d0 * 32);
                p0 = MFMA32(a0, qf[d0], p0); p1 = MFMA32(a1, qf[d0], p1);
            }
            const int pbase_u = q0 - 128 + (kt - 4) * 64;
            if (kt >= 4 && (kt == 4 || kt == 8 || pbase_u < 0 || pbase_u + 64 > SEQ)) {
                const int pbase = pbase_u;
#pragma unroll
                for (int i = 0; i < 16; ++i) {
                    const int k0 = pbase + crow(i, h), k1 = k0 + 32; const int d0 = k0 - qpos, d1 = k1 - qpos;
                    const bool v0 = k0 >= 0 && k0 < SEQ && d0 <= 128 && d0 >= -128, v1 = k1 >= 0 && k1 < SEQ && d1 <= 128 && d1 >= -128;
                    if (!v0) p0[i] = -INFINITY; if (!v1) p1[i] = -INFINITY;
                }
            }
            float mt = p0[0];
#pragma unroll
            for (int i = 1; i < 16; ++i) mt = fmaxf(mt, p0[i]);
#pragma unroll
            for (int i = 0; i < 16; ++i) mt = fmaxf(mt, p1[i]);
            mt = fmaxf(mt, __shfl_xor(mt, 32));
            const float mn = fmaxf(m_run, mt), alpha = __builtin_amdgcn_exp2f(m_run - mn); m_run = mn;
            float ls = 0.f;
#pragma unroll
            for (int i = 0; i < 16; ++i) { p0[i] = __builtin_amdgcn_exp2f(p0[i] - mn); ls += p0[i]; p1[i] = __builtin_amdgcn_exp2f(p1[i] - mn); ls += p1[i]; }
            l_run = l_run * alpha + ls;
            if (__any(alpha != 1.0f)) {
#pragma unroll
                for (int i = 0; i < 16; ++i) { o0[i] *= alpha; o1[i] *= alpha; }
            }
#pragma unroll
            for (int hf = 0; hf < 2; ++hf)
#pragma unroll
                for (int s = 0; s < 2; ++s) {
                    const bf16x8 pb = hf == 0 ? pack8(p0[8 * s], p0[8 * s + 1], p0[8 * s + 2], p0[8 * s + 3], p0[8 * s + 4], p0[8 * s + 5], p0[8 * s + 6], p0[8 * s + 7])
                                              : pack8(p1[8 * s], p1[8 * s + 1], p1[8 * s + 2], p1[8 * s + 3], p1[8 * s + 4], p1[8 * s + 5], p1[8 * s + 6], p1[8 * s + 7]);
                    const int kk = kt * 64 + 32 * hf + 16 * s + 4 * h;
                    { const LAS unsigned char* vp = Vs + r * VST + kk * 2; const s16x4 lo = *(const LAS s16x4*)vp, hi = *(const LAS s16x4*)(vp + 16);
                      o0 = MFMA32(__builtin_shufflevector(lo, hi, 0, 1, 2, 3, 4, 5, 6, 7), pb, o0); }
                    { const LAS unsigned char* vp = Vs + (32 + r) * VST + kk * 2; const s16x4 lo = *(const LAS s16x4*)vp, hi = *(const LAS s16x4*)(vp + 16);
                      o1 = MFMA32(__builtin_shufflevector(lo, hi, 0, 1, 2, 3, 4, 5, 6, 7), pb, o1); }
                }
        }
        const float inv = 1.0f / (l_run + __shfl_xor(l_run, 32));
        bf16_t* op = O + qrow * 1024 + hq * 64 + 4 * h;
#pragma unroll
        for (int gi = 0; gi < 4; ++gi) {
            u32x2 a; a.x = cvt_pk_bf16(o0[4 * gi] * inv, o0[4 * gi + 1] * inv); a.y = cvt_pk_bf16(o0[4 * gi + 2] * inv, o0[4 * gi + 3] * inv); *(u32x2*)(op + 8 * gi) = a;
            u32x2 c; c.x = cvt_pk_bf16(o1[4 * gi] * inv, o1[4 * gi + 1] * inv); c.y = cvt_pk_bf16(o1[4 * gi + 2] * inv, o1[4 * gi + 3] * inv); *(u32x2*)(op + 32 + 8 * gi) = c;
        }
        __syncthreads();
    }
}

typedef short v4i16_t __attribute__((ext_vector_type(4)));
DI s16x4 tr4(const LAS unsigned char* p) { return __builtin_bit_cast(s16x4, __builtin_amdgcn_ds_read_tr16_b64_v4i16((LAS v4i16_t*)p)); }
constexpr int S_BM = 0, S_CM = 34816, S_XS = 69632, S_XW = 79872, S_HB = 90112, S_AR = 98816, AR_BYTES = 4160, S_CW = S_AR + 2 * AR_BYTES;
struct CW8 { float w0[8], w1[8], w2[8], bs[8]; };
DI void cw_load(CW8& c, const LAS float* cw) {
    *(f32x4*)&c.w0[0] = *(const LAS f32x4*)(cw); *(f32x4*)&c.w0[4] = *(const LAS f32x4*)(cw + 4);
    *(f32x4*)&c.w1[0] = *(const LAS f32x4*)(cw + 8); *(f32x4*)&c.w1[4] = *(const LAS f32x4*)(cw + 12);
    *(f32x4*)&c.w2[0] = *(const LAS f32x4*)(cw + 16); *(f32x4*)&c.w2[4] = *(const LAS f32x4*)(cw + 20);
    *(f32x4*)&c.bs[0] = *(const LAS f32x4*)(cw + 24); *(f32x4*)&c.bs[4] = *(const LAS f32x4*)(cw + 28);
}
DI void conv8(const u32x4& vm, const u32x4& v0, const u32x4& vp, const CW8& c, float* o) {
    const unsigned am[4] = {vm.x, vm.y, vm.z, vm.w}, a0[4] = {v0.x, v0.y, v0.z, v0.w}, ap[4] = {vp.x, vp.y, vp.z, vp.w};
#pragma unroll
    for (int e = 0; e < 4; ++e) {
        const float lo = c.bs[2 * e] + c.w0[2 * e] * bflo(am[e]) + c.w1[2 * e] * bflo(a0[e]) + c.w2[2 * e] * bflo(ap[e]);
        const float hi = c.bs[2 * e + 1] + c.w0[2 * e + 1] * bfhi(am[e]) + c.w1[2 * e + 1] * bfhi(a0[e]) + c.w2[2 * e + 1] * bfhi(ap[e]);
        o[2 * e] = silu_f(lo); o[2 * e + 1] = silu_f(hi);
    }
}

constexpr int CV_SEG = 16, CV_ITEMS = (MT / CV_SEG) * 8, CV_MAXK = 5;
struct ConvHalo { u32x4 top[CV_MAXK], bot[CV_MAXK]; };
DI void conv_bounds(int r0, int& lo, int& hi) { if (r0 < ML) { lo = r0 & ~4095; hi = lo + SEQ; } else { lo = ML + ((r0 - ML) & ~255); hi = lo + CTXL; } }
DI void conv_capture(ConvHalo& hh, const bf16_t* X, int gw, int NGW, int lane) {
#pragma unroll
    for (int k = 0; k < CV_MAXK; ++k) {
        const int item = gw + k * NGW; hh.top[k] = (u32x4){0u, 0u, 0u, 0u}; hh.bot[k] = hh.top[k];
        if (item < CV_ITEMS) { const int r0 = (item >> 3) * CV_SEG, ch = (item & 7) * 512 + lane * 8; int lo, hi; conv_bounds(r0, lo, hi);
            if (r0 > lo) hh.top[k] = *(const u32x4*)(X + (size_t)(r0 - 1) * NXBC + ch);
            if (r0 + CV_SEG < hi) hh.bot[k] = *(const u32x4*)(X + (size_t)(r0 + CV_SEG) * NXBC + ch); }
    }
}
DI void conv_apply(const bf16_t* HALO, bf16_t* X, const float* conv_w, const float* conv_b, int gw, int NGW, int lane) {
#pragma unroll 1
    for (int k = 0; k < CV_MAXK; ++k) {
        const int item = gw + k * NGW;
        if (item < CV_ITEMS) {
            const int r0 = (item >> 3) * CV_SEG, ch = (item & 7) * 512 + lane * 8;
            bf16_t* xp = X + (size_t)r0 * NXBC + ch;
            int lo, hi; conv_bounds(r0, lo, hi);
            u32x4 htop = (u32x4){0u, 0u, 0u, 0u}, hbot = htop;
            if (r0 > lo) htop = *(const u32x4*)(HALO + ((size_t)((r0 - 1) >> 4) * 2 + 1) * NXBC + ch);
            if (r0 + CV_SEG < hi) hbot = *(const u32x4*)(HALO + ((size_t)((r0 + CV_SEG) >> 4) * 2) * NXBC + ch);
            u32x4 rows[CV_SEG + 2]; rows[0] = htop; rows[CV_SEG + 1] = hbot;
#pragma unroll
            for (int t = 0; t < CV_SEG; ++t) rows[t + 1] = *(const u32x4*)(xp + (size_t)t * NXBC);
            CW8 c;
            *(f32x4*)&c.w0[0] = *(const f32x4*)(conv_w + ch); *(f32x4*)&c.w0[4] = *(const f32x4*)(conv_w + ch + 4);
            *(f32x4*)&c.w1[0] = *(const f32x4*)(conv_w + 4096 + ch); *(f32x4*)&c.w1[4] = *(const f32x4*)(conv_w + 4096 + ch + 4);
            *(f32x4*)&c.w2[0] = *(const f32x4*)(conv_w + 8192 + ch); *(f32x4*)&c.w2[4] = *(const f32x4*)(conv_w + 8192 + ch + 4);
            *(f32x4*)&c.bs[0] = *(const f32x4*)(conv_b + ch); *(f32x4*)&c.bs[4] = *(const f32x4*)(conv_b + ch + 4);
#pragma unroll
            for (int t = 0; t < CV_SEG; ++t) { float o[8]; conv8(rows[t], rows[t + 1], rows[t + 2], c, o);
                u32x4 pk; pk.x = cvt_pk_bf16(o[0], o[1]); pk.y = cvt_pk_bf16(o[2], o[3]); pk.z = cvt_pk_bf16(o[4], o[5]); pk.w = cvt_pk_bf16(o[6], o[7]);
                *(u32x4*)(xp + (size_t)t * NXBC) = pk; }
        }
    }
}
constexpr int G_BM = 0, G_CM = 17408, G_XS = 34816, G_XW = 39936, G_HB = 45056, G_AR = 53760, G_ARB = 2176, G_SZ = 58368;
DI void ssd_chunk64(int b, int dir, int st, int& row0, bool& lat, int& kk) {
    if (st < 4) { const int c = dir ? 3 - st : st; row0 = ML + b * 256 + 64 * c; lat = false; kk = 0; }
    else { kk = dir ? 67 - st : st - 4; row0 = b * SEQ + 64 * kk; lat = true; }
}
DI void ssd_scan64(LAS float* AR, bool fwdarr, bool own, int lane, float d, float A) {
    const float a = d * A; float incl = a;
#pragma unroll
    for (int o = 1; o < 64; o <<= 1) { const float v = __shfl_up(incl, o); if (lane >= o) incl += v; }
    const float tot = __shfl(incl, 63);
    if (fwdarr) {
        const float c = incl; const float cr = __shfl(c, (lane & ~15) | 15);
        AR[lane] = c; AR[128 + lane] = d; AR[384 + lane] = __expf(cr - c) * d;
        if (own) { AR[256 + lane] = __expf(tot - c) * d; AR[320 + lane] = __expf(c); if (lane == 0) AR[512] = __expf(tot); }
    } else {
        const float c = tot - (incl - a); const float cr = __shfl(c, lane & ~15);
        AR[64 + lane] = c; AR[192 + lane] = d; AR[448 + lane] = __expf(cr - c) * d;
        if (own) { AR[256 + lane] = __expf(tot - c) * d; AR[320 + lane] = __expf(c); if (lane == 0) AR[512] = __expf(tot); }
    }
}
DI void ssd_phase(LAS unsigned char* lds0, const bf16_t* XBC, const float* DT, bf16_t* Y, const float* A_log, const float* Dsk, int vcu, int G) {
    const int tid = threadIdx.x, lane = tid & 63, w = __builtin_amdgcn_readfirstlane(tid >> 6), fr = lane & 15, fq = lane >> 4, qq = (lane & 15) >> 2, pp = lane & 3;
    const int dir = w >> 2, wl = w & 3, gtid = tid & 255;
    LAS unsigned char* lds = lds0 + dir * G_SZ;
    const int chgrp = gtid & 15, rb = gtid >> 4, chg = gtid & 3, tx = gtid >> 2;
    const bool scanF = (dir == 0 && wl == 0), scanB = (dir == 0 && wl == 1) || (dir == 1 && wl == 0), scanner = scanF || scanB;
    for (int u = vcu; u < 256; u += G) {
        const int b = u >> 6, g = (u >> 3) & 7, hd = g * 4 + ((u >> 1) & 3), ph = u & 1;
        const float Af = -__expf(A_log[hd]), Ab = -__expf(A_log[32 + hd]), Dv = Dsk[hd];
        const int xch = hd * 64 + ph * 32;
        const int chB = 2048 + g * 128 + chgrp * 8, chC = chB + 1024, chX = xch + chg * 8;
        const float Aw = scanF ? Af : Ab; const int dcol = (scanF ? 0 : 32) + hd;
        f32x4 H[2][2];
#pragma unroll
        for (int pt = 0; pt < 2; ++pt) { H[pt][0] = (f32x4){0.f, 0.f, 0.f, 0.f}; H[pt][1] = H[pt][0]; }
        int row0, kk; bool lat;
        ssd_chunk64(b, dir, 0, row0, lat, kk);
        u32x4 vB[4], vC[4], vX;
#pragma unroll
        for (int q = 0; q < 4; ++q) { vB[q] = *(const u32x4*)(XBC + (size_t)(row0 + 4 * rb + q) * NXBC + chB); vC[q] = *(const u32x4*)(XBC + (size_t)(row0 + 4 * rb + q) * NXBC + chC); }
        vX = *(const u32x4*)(XBC + (size_t)(row0 + tx) * NXBC + chX);
        __syncthreads();
        if (scanner) ssd_scan64((LAS float*)(lds + G_AR), scanF, (dir == 0) == scanF, lane, DT[(size_t)(row0 + lane) * 64 + dcol], Aw);
        for (int st = 0; st < 68; ++st) {
            LAS float* AR = (LAS float*)(lds + G_AR + (st & 1) * G_ARB);
            LAS float* CF = AR; LAS float* CBK = AR + 64; LAS float* DTF = AR + 128; LAS float* DTB = AR + 192; LAS float* WST = AR + 256; LAS float* ECUM = AR + 320; LAS float* E2F = AR + 384; LAS float* E2B = AR + 448;
            const bool curlat = lat, need_diag = lat && dir == 0; const int currow0 = row0;
            const bool first = dir == 0 ? kk <= 31 : kk >= 32;
            asm volatile("s_waitcnt vmcnt(0)" ::: "memory");
            __syncthreads();
#pragma unroll
            for (int pt = 0; pt < 2; ++pt)
#pragma unroll
                for (int n2 = 0; n2 < 2; ++n2)
#pragma unroll
                    for (int jj = 0; jj < 4; ++jj) *(LAS bf16_t*)(lds + G_HB + (16 * pt + 4 * fq + jj) * 272 + (16 * (2 * wl + n2) + fr) * 2) = (bf16_t)(cvt_pk_bf16(H[pt][n2][jj], 0.f) & 0xffffu);
            const float ws_ = WST[tx];
#pragma unroll
            for (int q = 0; q < 4; ++q) { *(LAS u32x4*)(lds + G_BM + (4 * rb + q) * 272 + chgrp * 16) = vB[q]; *(LAS u32x4*)(lds + G_CM + (4 * rb + q) * 272 + chgrp * 16) = vC[q]; }
            { *(LAS u32x4*)(lds + G_XS + tx * 80 + chg * 16) = vX;
                u32x4 pk; pk.x = cvt_pk_bf16(bflo(vX.x) * ws_, bfhi(vX.x) * ws_); pk.y = cvt_pk_bf16(bflo(vX.y) * ws_, bfhi(vX.y) * ws_);
                pk.z = cvt_pk_bf16(bflo(vX.z) * ws_, bfhi(vX.z) * ws_); pk.w = cvt_pk_bf16(bflo(vX.w) * ws_, bfhi(vX.w) * ws_);
                *(LAS u32x4*)(lds + G_XW + tx * 80 + chg * 16) = pk; }
            __syncthreads();
            const int il = 16 * wl + fr;
            u32x2 yo0 = (u32x2){0u, 0u}, yo1 = yo0;
            if (curlat && !first) { const bf16_t* yp = Y + (size_t)(currow0 + il) * DIN + xch + 4 * fq; yo0 = *(const u32x2*)yp; yo1 = *(const u32x2*)(yp + 16); }
            float dn = 0.f;
            if (st + 1 < 68) {
                ssd_chunk64(b, dir, st + 1, row0, lat, kk);
#pragma unroll
                for (int q = 0; q < 4; ++q) { vB[q] = *(const u32x4*)(XBC + (size_t)(row0 + 4 * rb + q) * NXBC + chB); vC[q] = *(const u32x4*)(XBC + (size_t)(row0 + 4 * rb + q) * NXBC + chC); }
                vX = *(const u32x4*)(XBC + (size_t)(row0 + tx) * NXBC + chX);
                if (scanner) dn = DT[(size_t)(row0 + lane) * 64 + dcol];
            }
            bf16x8 cfr[4];
#pragma unroll
            for (int ks = 0; ks < 4; ++ks) cfr[ks] = *(const LAS bf16x8*)(lds + G_CM + il * 272 + (32 * ks + 8 * fq) * 2);
            f32x4 yacc[2]; yacc[0] = (f32x4){0.f, 0.f, 0.f, 0.f}; yacc[1] = yacc[0];
            if (need_diag) {
                const float cfi = CF[il], cbi = CBK[il];
                f32x4 ga[4];
#pragma unroll
                for (int jt = 0; jt < 4; ++jt) ga[jt] = (f32x4){0.f, 0.f, 0.f, 0.f};
#pragma unroll
                for (int ks = 0; ks < 4; ++ks) {
                    bf16x8 bfr[4];
#pragma unroll
                    for (int jt = 0; jt < 4; ++jt) bfr[jt] = *(const LAS bf16x8*)(lds + G_BM + (16 * jt + fr) * 272 + (32 * ks + 8 * fq) * 2);
#pragma unroll
                    for (int jt = 0; jt < 4; ++jt) ga[jt] = MFMA16(bfr[jt], cfr[ks], ga[jt]);
                }
                bf16x8 mfr[2];
#pragma unroll
                for (int uu = 0; uu < 2; ++uu) {
                    float val[8];
#pragma unroll
                    for (int hf = 0; hf < 2; ++hf) {
                        const int jt = 2 * uu + hf; const int j0 = 16 * jt + 4 * fq;
                        if (jt < wl) {
                            const float e1 = __expf(cfi - CF[16 * jt + 15]); const f32x4 e2 = *(const LAS f32x4*)(E2F + j0);
#pragma unroll
                            for (int jj = 0; jj < 4; ++jj) val[hf * 4 + jj] = ga[jt][jj] * (e1 * e2[jj]);
                        } else if (jt > wl) {
                            const float e1 = __expf(cbi - CBK[16 * jt]); const f32x4 e2 = *(const LAS f32x4*)(E2B + j0);
#pragma unroll
                            for (int jj = 0; jj < 4; ++jj) val[hf * 4 + jj] = ga[jt][jj] * (e1 * e2[jj]);
                        } else {
                            const f32x4 cfj = *(const LAS f32x4*)(CF + j0), cbj = *(const LAS f32x4*)(CBK + j0), dfj = *(const LAS f32x4*)(DTF + j0), dbj = *(const LAS f32x4*)(DTB + j0);
#pragma unroll
                            for (int jj = 0; jj < 4; ++jj) { const int j = j0 + jj;
                                const float mf = (j <= il) ? __expf(fminf(cfi - cfj[jj], 0.f)) * dfj[jj] : 0.f;
                                const float mb = (j >= il) ? __expf(fminf(cbi - cbj[jj], 0.f)) * dbj[jj] : 0.f;
                                val[hf * 4 + jj] = ga[jt][jj] * (mf + mb); }
                        }
                    }
                    mfr[uu] = pack8(val[0], val[1], val[2], val[3], val[4], val[5], val[6], val[7]);
                }
                bf16x8 xfr[2][2];
#pragma unroll
                for (int pt = 0; pt < 2; ++pt)
#pragma unroll
                    for (int uu = 0; uu < 2; ++uu) {
                        const s16x4 lo = tr4(lds + G_XS + (32 * uu + 4 * fq + qq) * 80 + pt * 32 + pp * 8), hi = tr4(lds + G_XS + (32 * uu + 16 + 4 * fq + qq) * 80 + pt * 32 + pp * 8);
                        xfr[pt][uu] = __builtin_shufflevector(lo, hi, 0, 1, 2, 3, 4, 5, 6, 7);
                    }
#pragma unroll
                for (int uu = 0; uu < 2; ++uu)
#pragma unroll
                    for (int pt = 0; pt < 2; ++pt) yacc[pt] = MFMA16(xfr[pt][uu], mfr[uu], yacc[pt]);
            }
            if (curlat) {
                const float ec = ECUM[il];
#pragma unroll
                for (int pt = 0; pt < 2; ++pt) {
                    f32x4 oa = (f32x4){0.f, 0.f, 0.f, 0.f};
                    bf16x8 hfr[4];
#pragma unroll
                    for (int ks = 0; ks < 4; ++ks) hfr[ks] = *(const LAS bf16x8*)(lds + G_HB + (16 * pt + fr) * 272 + (32 * ks + 8 * fq) * 2);
#pragma unroll
                    for (int ks = 0; ks < 4; ++ks) oa = MFMA16(hfr[ks], cfr[ks], oa);
                    f32x4 yv = yacc[pt] + oa * ec;
                    if (dir == 0) { const u32x2 xv = *(const LAS u32x2*)(lds + G_XS + il * 80 + (16 * pt + 4 * fq) * 2);
                        yv[0] += Dv * bflo(xv.x); yv[1] += Dv * bfhi(xv.x); yv[2] += Dv * bflo(xv.y); yv[3] += Dv * bfhi(xv.y); }
                    if (!first) { const u32x2 old = pt == 0 ? yo0 : yo1; yv[0] += bflo(old.x); yv[1] += bfhi(old.x); yv[2] += bflo(old.y); yv[3] += bfhi(old.y); }
                    u32x2 o; o.x = cvt_pk_bf16(yv[0], yv[1]); o.y = cvt_pk_bf16(yv[2], yv[3]);
                    *(u32x2*)(Y + (size_t)(currow0 + il) * DIN + xch + 16 * pt + 4 * fq) = o;
                }
            }
            { const float dec = AR[512];
#pragma unroll
              for (int pt = 0; pt < 2; ++pt) { H[pt][0] = H[pt][0] * dec; H[pt][1] = H[pt][1] * dec; } }
            {
                bf16x8 bq[2][2], xq[2][2];
#pragma unroll
                for (int ks = 0; ks < 2; ++ks) {
#pragma unroll
                    for (int n2 = 0; n2 < 2; ++n2) {
                        const s16x4 blo = tr4(lds + G_BM + (32 * ks + 8 * fq + qq) * 272 + (2 * wl + n2) * 32 + pp * 8), bhi = tr4(lds + G_BM + (32 * ks + 8 * fq + 4 + qq) * 272 + (2 * wl + n2) * 32 + pp * 8);
                        bq[n2][ks] = __builtin_shufflevector(blo, bhi, 0, 1, 2, 3, 4, 5, 6, 7);
                    }
#pragma unroll
                    for (int pt = 0; pt < 2; ++pt) {
                        const s16x4 lo = tr4(lds + G_XW + (32 * ks + 8 * fq + qq) * 80 + pt * 32 + pp * 8), hi = tr4(lds + G_XW + (32 * ks + 8 * fq + 4 + qq) * 80 + pt * 32 + pp * 8);
                        xq[pt][ks] = __builtin_shufflevector(lo, hi, 0, 1, 2, 3, 4, 5, 6, 7);
                    }
                }
#pragma unroll
                for (int ks = 0; ks < 2; ++ks)
#pragma unroll
                    for (int pt = 0; pt < 2; ++pt)
#pragma unroll
                        for (int n2 = 0; n2 < 2; ++n2) H[pt][n2] = MFMA16(xq[pt][ks], bq[n2][ks], H[pt][n2]);
            }
            if (st + 1 < 68 && scanner) ssd_scan64((LAS float*)(lds + G_AR + ((st + 1) & 1) * G_ARB), scanF, (dir == 0) == scanF, lane, dn, Aw);
        }
        asm volatile("s_waitcnt vmcnt(0)" ::: "memory");
        __syncthreads();
    }
}

#define XB_TMO      128
#define XB_XCNT(j)  (256  + 64 * (j))
#define XB_XSUB(j)  (1280 + 64 * (j))
#define XB_XGEN(j)  (2304 + 64 * (j))
#define XB_TOP      3328
#define XB_TOPGEN   3392
#define XCD_BAR_WORDS 3456
#define XB_SPIN_CAP (1u << 18)

__device__ __forceinline__ unsigned xb_ld(unsigned* p)              { return __hip_atomic_load(p, __ATOMIC_RELAXED, __HIP_MEMORY_SCOPE_AGENT); }
__device__ __forceinline__ unsigned xb_add(unsigned* p, unsigned v) { return __hip_atomic_fetch_add(p, v, __ATOMIC_RELAXED, __HIP_MEMORY_SCOPE_AGENT); }
__device__ __forceinline__ unsigned xb_xcc_id() { return (unsigned)__builtin_amdgcn_s_getreg((3 << 11) | 20) & 0xFu; }
#define XB_SPIN(cond, bar) do { unsigned _sp = 0; while (cond) { __builtin_amdgcn_s_sleep(1); \
    if ((++_sp & 255u) == 0u) { if (xb_ld(&(bar)[XB_TMO])) break; if (_sp > XB_SPIN_CAP) { atomicAdd(&(bar)[XB_TMO], 1u); break; } } } } while (0)

struct XcdBarrier {
    unsigned* bar; unsigned x;
    volatile LAS unsigned* st;
};

__device__ __forceinline__ XcdBarrier xcd_barrier_post(unsigned* bar, volatile LAS unsigned* st) {
    XcdBarrier b; b.bar = bar; b.x = xb_xcc_id(); b.st = st;
    if (threadIdx.x == 0) (void)xb_add(&bar[XB_XCNT(b.x)], 1u);
    return b;
}
__device__ __forceinline__ void xcd_barrier_complete(unsigned* bar, unsigned x, unsigned& nloc, unsigned& nx) {
    const unsigned G = gridDim.x * gridDim.y * gridDim.z;
    unsigned sum, cnt, mine, sp = 0u;
    for (;;) {
        sum = 0u; cnt = 0u; mine = 0u;
#pragma unroll
        for (unsigned j = 0; j < 16; ++j) { const unsigned c = xb_ld(&bar[XB_XCNT(j)]); sum += c; cnt += (c > 0u) ? 1u : 0u; mine = (j == x) ? c : mine; }
        if (sum == G) break;
        __builtin_amdgcn_s_sleep(1);
        if ((++sp & 255u) == 0u) { if (xb_ld(&bar[XB_TMO])) break; if (sp > XB_SPIN_CAP) { atomicAdd(&bar[XB_TMO], 1u); break; } }
    }
    nloc = mine > 0u ? mine : 1u; nx = cnt > 0u ? cnt : 1u;
}

__device__ __forceinline__ void xcd_barrier(const XcdBarrier& b) {
    asm volatile("s_waitcnt vmcnt(0)" ::: "memory");
    __syncthreads();
    if (threadIdx.x == 0) {
        unsigned* bar = b.bar;
        __builtin_amdgcn_s_waitcnt(0);
        unsigned nloc = b.st[0], nx = b.st[1];
        if (nloc == 0u) { xcd_barrier_complete(bar, b.x, nloc, nx); b.st[0] = nloc; b.st[1] = nx; }
        const unsigned old = xb_add(&bar[XB_XSUB(b.x)], 1u);
        const unsigned gen = old / nloc;
        if (old + 1u == (gen + 1u) * nloc) {
            __builtin_amdgcn_fence(__ATOMIC_RELEASE, "agent");
            asm volatile("s_waitcnt vmcnt(0)" ::: "memory");
            const unsigned og = xb_add(&bar[XB_TOP], 1u);
            const unsigned tg = og / nx;
            if (og + 1u == (tg + 1u) * nx) xb_add(&bar[XB_TOPGEN], 1u);
            else XB_SPIN(xb_ld(&bar[XB_TOPGEN]) == tg, bar);
            __builtin_amdgcn_fence(__ATOMIC_ACQUIRE, "agent");
            xb_add(&bar[XB_XGEN(b.x)], 1u);
            asm volatile("s_waitcnt vmcnt(0)" ::: "memory");
        } else {
            XB_SPIN(xb_ld(&bar[XB_XGEN(b.x)]) == gen, bar);
            __builtin_amdgcn_fence(__ATOMIC_ACQUIRE, "agent");
            asm volatile("s_waitcnt vmcnt(0)" ::: "memory");
        }
    }
    __syncthreads();
}

constexpr int NPHASE = 18;
#define DUPMASK 0x4
#define DUP(k) ((DUPMASK >> (k)) & 1)
#define REP_ATT 1
#define REP_SSD 1
#define REP_GEMM 1
#define REP_NORM 1
#define XSYNC 0
#ifndef PHMASK
#define PHMASK 0x3ffff
#endif
#define PHON(k) ((PHMASK >> (k)) & 1)
template <bool COOP>
__global__ void __launch_bounds__(512) mega(Params P) {
    extern __shared__ __attribute__((aligned(16))) unsigned char lds_raw[];
    LAS unsigned char* lds = (LAS unsigned char*)lds_raw;
    const int tid = threadIdx.x, lane = tid & 63, wave = __builtin_amdgcn_readfirstlane(tid >> 6);
    const int G = gridDim.x; const int bx = blockIdx.x; const int vcu = (G % 8 == 0) ? (bx % 8) * (G / 8) + bx / 8 : bx;
    const int gw = vcu * 8 + wave, NGW = G * 8;
    unsigned char* ws = P.ws;
#define MOD ((float*)(P.ws + WS_MOD))
#define rope ((const float*)(P.ws + WS_ROPE))
#define CTXR ((float*)(P.ws + WS_CTXR))
#define HN ((bf16_t*)(P.ws + WS_HN))
#define DTb ((float*)(P.ws + WS_DT))
#define x_in (P.in[0])
#define ctx_in (P.in[2])
#define xo (P.out)
    const int lo = P.ph_lo, hi = P.ph_hi;
    volatile LAS unsigned* xst = (volatile LAS unsigned*)(lds + 159984);
    if (tid < 2) xst[tid] = 0u;
    __syncthreads();
    XcdBarrier xb = xcd_barrier_post((unsigned*)(ws + WS_BAR), xst);
    if (hi > 1000) cg::this_grid().sync();
#define IN(k) (PHON(k) && lo <= (k) && (k) < hi)
#define SYNC(k) do { if ((k) + 1 < hi) { xcd_barrier(xb); } } while (0)
#define NORM_PH(k, layer, second, xL, xC, nrows, NS_, goff_) if (IN(k)) { \
        const CtxPart cp{(const float*)(ws + WS_PARTA), (const float*)(ws + WS_PARTB), MOD + 4 * 6144 + (goff_), CTXR, NS_}; \
        for (int rep = 0; rep < REP_NORM; ++rep) norm_phase(xL, xC, ((second) ? P.in[7] : P.in[6]) + (layer) * 1024, MOD + (layer) * 5 * 6144, (second) ? 3072 : 0, (second) ? 4096 : 1024, HN, nrows, gw, NGW, lane, cp); SYNC(k); }
#define RES_PH(k, Aoff, Boff, M_, K_, bL, bC, goff) if (IN(k)) { \
        pg8::Gemm gm{(const bf16_t*)(ws + (Aoff)), (const bf16_t*)(ws + (Boff)), M_, 1024, K_, K_}; pg8::StaticOrder S; S.init(M_, 1024, G, bx); \
        EpiRes E{bL, bC, xo, CTXR, MOD + (goff)}; pg8::gemm_phase<EpiRes, pg8::StaticOrder, true, true>(lds, gm, S, E); if ((k) != 4 && (k) != 7) SYNC(k); }
#define RESCTX_PH(k, Aoff, Boff, K_, NS) if (IN(k)) { \
        pg8::Gemm gm{(const bf16_t*)(ws + (Aoff)), (const bf16_t*)(ws + (Boff)), MT, 1024, (K_) / (NS), K_}; pg8::SplitOrder S{64, 4, 4, NS, G, bx}; \
        EpiPart E{(float*)(ws + WS_PARTA), (float*)(ws + WS_PARTB)}; pg8::gemm_phase<EpiPart, pg8::SplitOrder, true, true>(lds, gm, S, E); SYNC(k); }
#define SWI_PH(k, Boff, Hoff, M_) if (IN(k)) { \
        pg8::Gemm gm{HN, (const bf16_t*)(ws + (Boff)), M_, 2 * DFF, 1024, 1024}; pg8::StaticOrder S; S.init(M_, 2 * DFF, G, bx); \
        EpiSwi E{(bf16_t*)(ws + (Hoff))}; for (int rep = 0; rep < REP_GEMM; ++rep) pg8::gemm_phase<EpiSwi, pg8::StaticOrder, true, true>(lds, gm, S, E); SYNC(k); }

    if (IN(0)) { phase0(P, lds, vcu, G); SYNC(0); for (int rep = 0; rep < XSYNC; ++rep) xcd_barrier(xb); }
    NORM_PH(1, 0, false, x_in, ctx_in, MT, 0, 0)
    if (IN(2)) {
        pg8::Gemm gm{HN, (const bf16_t*)(ws + WS_WQKV), MT, 1536, 1024, 1024}; pg8::StaticOrder S; S.init(MT, 1536, G, bx);
        EpiQKV E{(bf16_t*)(ws + WS_Q), (bf16_t*)(ws + WS_K), (bf16_t*)(ws + WS_VT), rope};
        for (int rep = 0; rep < REP_GEMM; ++rep) pg8::gemm_phase<EpiQKV, pg8::StaticOrder, true, true>(lds, gm, S, E); SYNC(2);
    }
    if (IN(3)) { for (int rep = 0; rep < REP_ATT; ++rep) attn_phase(lds, (const bf16_t*)(ws + WS_Q), HN, (const bf16_t*)(ws + WS_K), (const bf16_t*)(ws + WS_VT), P.in[10], vcu, G); SYNC(3); }
    RES_PH(4, WS_HN, WS_WO, ML, 1024, x_in, ctx_in, 2048)
    RESCTX_PH(4, WS_HN, WS_WO, 1024, 4)
    NORM_PH(5, 0, true, xo, ctx_in, MT, 4, 2048)
    SWI_PH(6, WS_GU0, WS_HB0, MT)
    RES_PH(7, WS_HB0, WS_DN0, ML, DFF, xo, CTXR, 5120)
    RESCTX_PH(7, WS_HB0, WS_DN0, DFF, 11)
    NORM_PH(8, 1, false, xo, CTXR, MT, 11, 5120)
    if (IN(9)) {
        pg8::Gemm gm{HN, (const bf16_t*)(ws + WS_WXBC), MT, NXBCP, 1024, 1024}; pg8::StaticOrder S; S.init(MT, NXBCP, G, bx);
        EpiXbc E{(bf16_t*)(ws + WS_XBC), DTb, P.in[14], (bf16_t*)(ws + WS_HALO)};
        for (int rep = 0; rep < REP_GEMM; ++rep) pg8::gemm_phase<EpiXbc, pg8::StaticOrder, true, true>(lds, gm, S, E); SYNC(9);
    }
    if (IN(10)) {
        conv_apply((const bf16_t*)(ws + WS_HALO), (bf16_t*)(ws + WS_XBC), P.in[12], P.in[13], gw, NGW, lane);
        xcd_barrier(xb);
        for (int rep = 0; rep < REP_SSD; ++rep) ssd_phase(lds, (const bf16_t*)(ws + WS_XBC), DTb, (bf16_t*)(ws + WS_Y), P.in[15], P.in[16], vcu, G); SYNC(10); }
    if (IN(11)) {
        pg8::Gemm gm{HN, (const bf16_t*)(ws + WS_WZ), ML, DIN, 1024, 1024}; pg8::StaticOrder S; S.init(ML, DIN, G, bx);
        EpiZ E{(bf16_t*)(ws + WS_Y), P.in[17], (LAS float*)(lds + 132096)};
        pg8::gemm_phase<EpiZ, pg8::StaticOrder, true, true>(lds, gm, S, E); SYNC(11);
    }
    RES_PH(13, WS_Y, WS_WOUT, ML, DIN, xo, CTXR, 5 * 6144 + 2048)
    if (IN(14)) phase_conv_ffn1(P, lds, vcu, G);
    NORM_PH(14, 1, true, xo, CTXR, ML, 0, 0)
    SWI_PH(15, WS_GU1, WS_HB1, ML)
    RES_PH(16, WS_HB1, WS_DN1, ML, DFF, xo, CTXR, 5 * 6144 + 5120)
    if (IN(17)) { final_norm_phase(xo, P.in[22], gw, NGW, lane); }
}

extern "C" void kernel_launch(void* const* d_in, const int* in_sizes, int n_in, void* d_out, int out_size, void* d_ws, size_t ws_size, hipStream_t stream) {
    static int grid = 0;
    if (grid == 0) {
        if (n_in != 23 || out_size != ML * DM || ws_size < WS_END) { fprintf(stderr, "kernel_launch: unexpected shapes (n_in %d out %d ws %zu)\n", n_in, out_size, ws_size); grid = -1; return; }
        int dev = 0, cus = 0, per_cu = 0;
        (void)hipGetDevice(&dev); (void)hipDeviceGetAttribute(&cus, hipDeviceAttributeMultiprocessorCount, dev);
        (void)hipFuncSetAttribute((const void*)mega<true>, hipFuncAttributeMaxDynamicSharedMemorySize, LDS_BYTES);
        (void)hipOccupancyMaxActiveBlocksPerMultiprocessor(&per_cu, (const void*)mega<true>, 512, LDS_BYTES);
        if (per_cu < 1) fprintf(stderr, "kernel_launch: occupancy query says %d blocks/CU\n", per_cu);
        (void)hipGetLastError();
        grid = cus >= 256 ? 256 : cus;
        if (grid <= 0) grid = 256;
    }
    if (grid < 0) return;
    (void)hipMemsetAsync((char*)d_ws, 0, CTL_BYTES, stream);
    Params p{};
    for (int i = 0; i < 23; ++i) p.in[i] = (const float*)d_in[i];
    p.out = (float*)d_out; p.ws = (unsigned char*)d_ws;
    p.ph_lo = 0; p.ph_hi = NPHASE;
    void* args[] = {&p};
    hipError_t e = hipLaunchCooperativeKernel((const void*)mega<true>, dim3(grid), dim3(512), args, LDS_BYTES, stream);
    if (e != hipSuccess) fprintf(stderr, "cooperative launch failed: %s (grid %d)\n", hipGetErrorString(e), grid);
}
```
